# Optimizing an MI355X kernel written in HIP

```python
import math
import jax, jax.numpy as jnp
from jax import lax
import numpy as np

D_MODEL = 1024
BATCH = 4
SEQ = 4096
DEPTH = 4

HEAD_DIM = 64
V_DIM = 2 * HEAD_DIM
ATTN_W = D_MODEL // 2
N_HEADS = ATTN_W // V_DIM
QK_W = N_HEADS * 2 * HEAD_DIM
CONV_W = D_MODEL // 2
CONV_K = 3
N_CONV_GROUPS = 8
D_FF = (((8 * D_MODEL) // 3 + 255) // 256) * 256
NUM_BUCKETS = 32
MAX_EXACT = NUM_BUCKETS // 2
MAX_DISTANCE = 128
Q_BLOCK = 128
NORM_EPS = 1e-6
SUBLN_EPS = 1e-5
COL_SIZES = (QK_W, QK_W, ATTN_W, CONV_W, CONV_W, CONV_W, D_MODEL, D_MODEL)
IN_COLS = sum(COL_SIZES)

kernel_name = "hybrid_diffattn_shortconv_macaron"


def rmsnorm(x, g, eps=NORM_EPS):
    xf = x.astype(jnp.float32)
    y = xf * lax.rsqrt(jnp.mean(xf * xf, axis=-1, keepdims=True) + eps)
    return (y * g.astype(jnp.float32)).astype(x.dtype)


def swiglu(h, w_gate, w_up, w_down):
    return (jax.nn.silu(h @ w_gate) * (h @ w_up)) @ w_down


def t5_causal_bucket(dist):
    n = jnp.maximum(dist, 0)
    is_small = n < MAX_EXACT
    nf = jnp.maximum(n, MAX_EXACT).astype(jnp.float32)
    large = MAX_EXACT + (jnp.log(nf / MAX_EXACT) / math.log(MAX_DISTANCE / MAX_EXACT)
                         * (NUM_BUCKETS - MAX_EXACT)).astype(jnp.int32)
    large = jnp.minimum(large, NUM_BUCKETS - 1)
    return jnp.where(is_small, n, large)


def diff_attention(q1, q2, k1, k2, v, rel_bias, lam):
    T = q1.shape[2]
    n_blocks = T // Q_BLOCK
    k_pos = jnp.arange(T, dtype=jnp.int32)

    def one_block(i):
        start = i * Q_BLOCK
        q1b = lax.dynamic_slice_in_dim(q1, start, Q_BLOCK, axis=2)
        q2b = lax.dynamic_slice_in_dim(q2, start, Q_BLOCK, axis=2)
        q_pos = start + jnp.arange(Q_BLOCK, dtype=jnp.int32)
        dist = q_pos[:, None] - k_pos[None, :]
        bias = jnp.transpose(rel_bias.astype(jnp.float32)[t5_causal_bucket(dist)], (2, 0, 1))
        visible = dist >= 0
        s1 = jnp.einsum('bhqd,bhkd->bhqk', q1b, k1).astype(jnp.float32) + bias
        s2 = jnp.einsum('bhqd,bhkd->bhqk', q2b, k2).astype(jnp.float32) + bias
        p1 = jax.nn.softmax(jnp.where(visible, s1, -jnp.inf), axis=-1)
        p2 = jax.nn.softmax(jnp.where(visible, s2, -jnp.inf), axis=-1)
        p = (p1 - lam * p2).astype(v.dtype)
        return jnp.einsum('bhqk,bhkd->bhqd', p, v)

    out = lax.map(one_block, jnp.arange(n_blocks, dtype=jnp.int32))
    nb, b, h, qb, dv = out.shape
    return jnp.transpose(out, (1, 0, 3, 2, 4)).reshape(b, nb * qb, h, dv)


def causal_depthwise_conv(u, w):
    c = u.shape[-1]
    return lax.conv_general_dilated(
        u, w[:, None, :].astype(u.dtype), window_strides=(1,), padding=[(CONV_K - 1, 0)],
        dimension_numbers=('NWC', 'WIO', 'NWC'), feature_group_count=c)


def setup_inputs(seed: int = 0) -> dict:
    key = jax.random.key(seed)
    ks = jax.random.split(key, 24)
    nrm = lambda k, shape, fan_in, s=1.0: jax.random.normal(k, shape, jnp.float32) * (s * fan_in ** -0.5)
    gain = lambda k, shape: 1.0 + 0.05 * jax.random.normal(k, shape, jnp.float32)
    return {
        "x": jax.random.normal(ks[0], (BATCH, SEQ, D_MODEL), jnp.float32),
        "norm_ffn1_g": gain(ks[1], (DEPTH, D_MODEL)),
        "ffn1_w_gate": nrm(ks[2], (DEPTH, D_MODEL, D_FF), D_MODEL),
        "ffn1_w_up": nrm(ks[3], (DEPTH, D_MODEL, D_FF), D_MODEL),
        "ffn1_w_down": nrm(ks[4], (DEPTH, D_FF, D_MODEL), D_FF),
        "norm_mix_g": gain(ks[5], (DEPTH, D_MODEL)),
        "w_in": nrm(ks[6], (DEPTH, D_MODEL, IN_COLS), D_MODEL),
        "lambda_q1": 0.1 * jax.random.normal(ks[7], (DEPTH, HEAD_DIM), jnp.float32),
        "lambda_k1": 0.1 * jax.random.normal(ks[8], (DEPTH, HEAD_DIM), jnp.float32),
        "lambda_q2": 0.1 * jax.random.normal(ks[9], (DEPTH, HEAD_DIM), jnp.float32),
        "lambda_k2": 0.1 * jax.random.normal(ks[10], (DEPTH, HEAD_DIM), jnp.float32),
        "subln_g": gain(ks[11], (DEPTH, V_DIM)),
        "rel_bias": 0.5 * jax.random.normal(ks[12], (NUM_BUCKETS, N_HEADS), jnp.float32),
        "conv_w": nrm(ks[13], (DEPTH, CONV_K, CONV_W), CONV_K),
        "w_branch_attn": nrm(ks[14], (DEPTH, ATTN_W, D_MODEL), ATTN_W),
        "w_branch_conv": nrm(ks[15], (DEPTH, CONV_W, D_MODEL), CONV_W),
        "w_out": nrm(ks[16], (DEPTH, D_MODEL, D_MODEL), D_MODEL),
        "norm_ffn2_g": gain(ks[17], (DEPTH, D_MODEL)),
        "ffn2_w_gate": nrm(ks[18], (DEPTH, D_MODEL, D_FF), D_MODEL),
        "ffn2_w_up": nrm(ks[19], (DEPTH, D_MODEL, D_FF), D_MODEL),
        "ffn2_w_down": nrm(ks[20], (DEPTH, D_FF, D_MODEL), D_FF),
        "final_g": gain(ks[21], (D_MODEL,)),
    }


def reference(x, norm_ffn1_g, ffn1_w_gate, ffn1_w_up, ffn1_w_down, norm_mix_g, w_in,
              lambda_q1, lambda_k1, lambda_q2, lambda_k2, subln_g, rel_bias, conv_w,
              w_branch_attn, w_branch_conv, w_out, norm_ffn2_g, ffn2_w_gate, ffn2_w_up,
              ffn2_w_down, final_g):
    B, T, _ = x.shape
    split_idx = list(np.cumsum(COL_SIZES)[:-1])
    q_scale = HEAD_DIM ** -0.5
    for l in range(DEPTH):
        lambda_init = 0.8 - 0.6 * math.exp(-0.3 * l)

        x = x + 0.5 * swiglu(rmsnorm(x, norm_ffn1_g[l]), ffn1_w_gate[l], ffn1_w_up[l], ffn1_w_down[l])

        h = rmsnorm(x, norm_mix_g[l])
        proj = h @ w_in[l]
        q, k, v, c_b, c_c, c_u, g_attn, g_conv = jnp.split(proj, split_idx, axis=-1)

        q = (q * q_scale).reshape(B, T, N_HEADS, 2, HEAD_DIM)
        k = k.reshape(B, T, N_HEADS, 2, HEAD_DIM)
        to_bhtd = lambda a: jnp.transpose(a, (0, 2, 1, 3))
        q1, q2 = to_bhtd(q[..., 0, :]), to_bhtd(q[..., 1, :])
        k1, k2 = to_bhtd(k[..., 0, :]), to_bhtd(k[..., 1, :])
        vh = to_bhtd(v.reshape(B, T, N_HEADS, V_DIM))
        lam = (jnp.exp(jnp.sum(lambda_q1[l].astype(jnp.float32) * lambda_k1[l].astype(jnp.float32)))
               - jnp.exp(jnp.sum(lambda_q2[l].astype(jnp.float32) * lambda_k2[l].astype(jnp.float32)))
               + lambda_init)
        attn = diff_attention(q1, q2, k1, k2, vh, rel_bias, lam)
        attn = rmsnorm(attn, subln_g[l], SUBLN_EPS) * (1.0 - lambda_init)
        y_attn = attn.reshape(B, T, ATTN_W) @ w_branch_attn[l]

        y_conv = (c_b * causal_depthwise_conv(c_c * c_u, conv_w[l])) @ w_branch_conv[l]

        merged = jax.nn.sigmoid(g_attn) * y_attn + jax.nn.sigmoid(g_conv) * y_conv
        x = x + merged @ w_out[l]

        x = x + 0.5 * swiglu(rmsnorm(x, norm_ffn2_g[l]), ffn2_w_gate[l], ffn2_w_up[l], ffn2_w_down[l])
    return rmsnorm(x, final_g)
```

```cpp
#include <hip/hip_runtime.h>
#include <hip/hip_cooperative_groups.h>
#include <cstdio>
#include <cstdint>
namespace cg = cooperative_groups;
namespace pg8 {
#define PG8_LAS __attribute__((address_space(3)))
typedef unsigned short bf16_t;
typedef short bf16x8 __attribute__((ext_vector_type(8)));
typedef float f32x4 __attribute__((ext_vector_type(4)));
typedef unsigned u32x4 __attribute__((ext_vector_type(4)));
constexpr int BM = 256, BK = 64, HALF = 128, HTB = HALF * BK * 2  , STAGE_BYTES = 8 * HTB, NXCD = 8, WGM = 8;

__host__ __device__ __forceinline__ int lds_byte(int r, int c) { const int st = (r >> 4) * 2 + (c >> 5), rr = r & 15, cc = c & 31, ob = rr * 64 + cc * 2; return st * 1024 + (ob ^ (((ob >> 9) & 1) << 5)); }
__host__ __device__ __forceinline__ void stage_rc(int b, int& R, int& C) { const int st = b / 1024, sb = b % 1024, swz = sb ^ (((sb >> 9) & 1) << 5); R = (st >> 1) * 16 + swz / 64; C = (st & 1) * 32 + (swz % 64) / 2; }
__host__ __device__ __forceinline__ int perm32(int rho) { const int n = rho >> 4, i = rho & 15; return 8 * (i >> 2) + 4 * n + (i & 3); }

struct Unit { int pm, pn, par; };
struct Gemm { const bf16_t* A; const bf16_t* Bt; int M, N, K; };

struct StaticOrder {
    int nM, nN, nwg, G, c;
    __host__ __device__ void init(int M, int N, int G_, int c_) { nM = M / BM; nN = N / BM; nwg = nM * nN; G = G_; c = c_; }
    __host__ __device__ bool next(int i, Unit& u) const {
        const long L = (long)i * G + c; if (L >= nwg) return false;
        int wgid = (int)L; { const int q = nwg / NXCD, r = nwg % NXCD, xcd = wgid % NXCD, off = wgid / NXCD; wgid = (xcd < r ? xcd * (q + 1) : r * (q + 1) + (xcd - r) * q) + off; }
        const int nig = WGM * nN, gid = wgid / nig, fm = gid * WGM, gsz = (nM - fm) < WGM ? (nM - fm) : WGM;
        u.pm = fm + ((wgid % nig) % gsz); u.pn = (wgid % nig) / gsz; return true;
    }
    __device__ __forceinline__ void a_ready(const Unit&) const {}
    __device__ __forceinline__ void done(const Unit&) const {}
};

__device__ __forceinline__ unsigned cvt_pk_bf16(float lo, float hi) { unsigned r; asm volatile("v_cvt_pk_bf16_f32 %0, %1, %2" : "=v"(r) : "v"(lo), "v"(hi)); return r; }
typedef float f32x2 __attribute__((ext_vector_type(2)));
template <class Epi, class Sched, bool ALIGN_EPI = false, bool SP2 = false>
__device__ __forceinline__ void gemm_phase(PG8_LAS unsigned char* lds, const Gemm g, const Sched& S, const Epi& E, const int tid,
                                           const bf16_t* nbB = nullptr, int nbK = 0, bool nbPerm = false, bool bpre = false) {
    const int wid = __builtin_amdgcn_readfirstlane(tid >> 6), lane = tid & 63, wr = wid >> 2, wc = wid & 3, fr = lane & 15, fq = lane >> 4;
    const int K = g.K, nt = K / BK;
    unsigned voffA[2], voffB[2];
#pragma unroll
    for (int i = 0; i < 2; ++i) { int R, C; stage_rc(tid * 16 + i * 8192, R, C); const int Rb = Epi::PERM ? ((R & ~31) + perm32(R & 31)) : R;
        voffA[i] = (unsigned)(R * K + C) * 2u; voffB[i] = (unsigned)(Rb * K + C) * 2u; }
    const size_t kstep = (size_t)(BK * 2);
    const size_t hstep = (size_t)HALF * K * 2;
    const size_t tstep = 2 * hstep;
    const unsigned ldsw = (unsigned)wid * 1024u;
    const int aoff = lds_byte(wr * 64 + fr, fq * 8), boff = lds_byte(wc * 32 + fr, fq * 8);
#define PG8_SA(b, h) (((b) * 2 + (h)) * HTB)
#define PG8_SB(b, h) ((4 + (b) * 2 + (h)) * HTB)
#define PG8_STAGE(bufoff, gbase, voff) do { _Pragma("unroll") for (int _i = 0; _i < 2; ++_i) \
        __builtin_amdgcn_global_load_lds((const unsigned*)((const char*)(gbase) + (voff)[_i]), (PG8_LAS unsigned*)(lds + (bufoff) + ldsw + _i * 8192), 16, 0, 0); } while (0)
#define PG8_LDA(dst, b, h) do { _Pragma("unroll") for (int m = 0; m < 4; ++m) _Pragma("unroll") for (int k = 0; k < 2; ++k) dst[m][k] = *(const PG8_LAS bf16x8*)(lds + PG8_SA(b, h) + aoff + m * 2048 + k * 1024); } while (0)
#define PG8_LDB(dst, b, h) do { _Pragma("unroll") for (int n = 0; n < 2; ++n) _Pragma("unroll") for (int k = 0; k < 2; ++k) dst[n][k] = *(const PG8_LAS bf16x8*)(lds + PG8_SB(b, h) + boff + n * 2048 + k * 1024); } while (0)
#define PG8_MMA(ai, bj, At, Bt) do { __builtin_amdgcn_s_setprio(1); _Pragma("unroll") for (int m = 0; m < 4; ++m) _Pragma("unroll") for (int n = 0; n < 2; ++n) _Pragma("unroll") for (int k = 0; k < 2; ++k) \
        acc[ai][bj][m][n] = __builtin_amdgcn_mfma_f32_16x16x32_bf16(Bt[n][k], At[m][k], acc[ai][bj][m][n], 0, 0, 0); __builtin_amdgcn_s_setprio(0); } while (0)
#define PG8_WAIT_V(n) asm volatile("s_waitcnt vmcnt(" #n ")" ::: "memory")
#define PG8_WAIT_L(n) asm volatile("s_waitcnt lgkmcnt(" #n ")" ::: "memory")
#define PG8_BAR __builtin_amdgcn_s_barrier()
#define PG8_SCHED __builtin_amdgcn_sched_barrier(0)
    Unit cur, nxt; int ui = 0;
    if (!S.next(0, cur)) return;
    cur.par = 0;
    if constexpr (Epi::HAS_PREP) { f32x4 pr_[4]; E.prep_load(cur.pm, tid, pr_); E.prep_store(0, tid, pr_); }
    f32x4 acc[2][2][4][2];
#pragma unroll
    for (int a = 0; a < 2; ++a)
#pragma unroll
        for (int b = 0; b < 2; ++b)
#pragma unroll
            for (int m = 0; m < 4; ++m)
#pragma unroll
                for (int n = 0; n < 2; ++n) acc[a][b][m][n] = (f32x4){0.f, 0.f, 0.f, 0.f};
    bf16x8 At[4][2], B0[2][2], B1[2][2];
    const char* cA = (const char*)g.A + (size_t)cur.pm * tstep; const char* cB = (const char*)g.Bt + (size_t)cur.pn * tstep;
    S.a_ready(cur);
    if constexpr (SP2) {
        if (bpre) {
            PG8_STAGE(PG8_SA(0, 0), cA, voffA); PG8_STAGE(PG8_SA(0, 1), cA + hstep, voffA);
            if (wr == 1) PG8_BAR;
            PG8_WAIT_V(2); PG8_BAR;
            PG8_STAGE(PG8_SA(1, 0), cA + kstep, voffA);
            PG8_WAIT_V(2); PG8_BAR;
        } else {
        PG8_STAGE(PG8_SB(0, 0), cB, voffB); PG8_STAGE(PG8_SB(0, 1), cB + hstep, voffB); PG8_STAGE(PG8_SA(0, 0), cA, voffA); PG8_STAGE(PG8_SA(0, 1), cA + hstep, voffA);
        if (wr == 1) PG8_BAR;
        PG8_WAIT_V(2); PG8_BAR;
        PG8_STAGE(PG8_SB(1, 0), cB + kstep, voffB); PG8_STAGE(PG8_SA(1, 0), cA + kstep, voffA); PG8_STAGE(PG8_SB(1, 1), cB + hstep + kstep, voffB);
        PG8_WAIT_V(6); PG8_BAR;
        }
    } else {
        PG8_STAGE(PG8_SB(0, 0), cB, voffB); PG8_STAGE(PG8_SA(0, 0), cA, voffA); PG8_STAGE(PG8_SB(0, 1), cB + hstep, voffB); PG8_STAGE(PG8_SA(0, 1), cA + hstep, voffA);
        if (wr == 1) PG8_BAR;
        PG8_WAIT_V(4); PG8_BAR;
        PG8_STAGE(PG8_SB(1, 0), cB + kstep, voffB); PG8_STAGE(PG8_SA(1, 0), cA + kstep, voffA); PG8_STAGE(PG8_SB(1, 1), cB + hstep + kstep, voffB);
        PG8_WAIT_V(6); PG8_BAR;
    }
    for (;;) {
        const bool has_next = S.next(ui + 1, nxt);
        const char* nA = has_next ? (const char*)g.A + (size_t)nxt.pm * tstep : cA; const char* nB = has_next ? (const char*)g.Bt + (size_t)nxt.pn * tstep : (nbB ? (const char*)nbB : cB);
        for (int t = 0; t < nt; t += 2) {
            const bool last = (t == nt - 2);
            const char* a1 = cA + (size_t)(t + 1) * kstep;
            const char* a2 = last ? nA : cA + (size_t)(t + 2) * kstep; const char* b2 = last ? nB : cB + (size_t)(t + 2) * kstep;
            const char* a3 = a2 + kstep; const char* b3 = b2 + kstep;
            unsigned vBn[2] = {voffB[0], voffB[1]}; size_t hB = hstep;
            if (last && !has_next && nbB) {
#pragma unroll
                for (int i = 0; i < 2; ++i) { int R, C; stage_rc(tid * 16 + i * 8192, R, C); const int Rb = nbPerm ? ((R & ~31) + perm32(R & 31)) : R; vBn[i] = (unsigned)(Rb * nbK + C) * 2u; }
                hB = (size_t)HALF * nbK * 2;
            }
            if (last && has_next) S.a_ready(nxt);
            if constexpr (SP2) {
            PG8_LDB(B0, 0, 0); PG8_LDB(B1, 0, 1); PG8_SCHED; PG8_LDA(At, 0, 0); PG8_STAGE(PG8_SA(1, 1), a1 + hstep, voffA);
            PG8_WAIT_V(8); PG8_WAIT_L(0); PG8_BAR; PG8_MMA(0, 0, At, B0); PG8_MMA(0, 1, At, B1); PG8_BAR; PG8_SCHED;
            PG8_LDA(At, 0, 1); PG8_STAGE(PG8_SB(0, 0), b2, vBn); PG8_STAGE(PG8_SB(0, 1), b2 + hB, vBn); PG8_STAGE(PG8_SA(0, 0), a2, voffA);
            PG8_WAIT_V(8); PG8_WAIT_L(0); PG8_BAR; PG8_MMA(1, 0, At, B0); PG8_MMA(1, 1, At, B1); PG8_BAR; PG8_SCHED;
            PG8_LDB(B0, 1, 0); PG8_LDB(B1, 1, 1); PG8_SCHED; PG8_LDA(At, 1, 0); PG8_STAGE(PG8_SA(0, 1), a2 + hstep, voffA);
            PG8_WAIT_V(8); PG8_WAIT_L(0); PG8_BAR; PG8_MMA(0, 0, At, B0); PG8_MMA(0, 1, At, B1); PG8_BAR; PG8_SCHED;
            PG8_LDA(At, 1, 1); PG8_STAGE(PG8_SB(1, 0), b3, vBn); PG8_STAGE(PG8_SB(1, 1), b3 + hB, vBn); PG8_STAGE(PG8_SA(1, 0), a3, voffA);
            PG8_WAIT_V(8); PG8_WAIT_L(0); PG8_BAR; PG8_MMA(1, 0, At, B0); PG8_MMA(1, 1, At, B1); PG8_BAR; PG8_SCHED;
            } else {
            PG8_LDB(B0, 0, 0); PG8_SCHED; PG8_LDA(At, 0, 0); PG8_STAGE(PG8_SA(1, 1), a1 + hstep, voffA);
            PG8_WAIT_L(8); PG8_BAR; PG8_WAIT_L(0); PG8_MMA(0, 0, At, B0); PG8_BAR; PG8_SCHED;
            PG8_LDB(B1, 0, 1); PG8_STAGE(PG8_SB(0, 0), b2, voffB);
            PG8_BAR; PG8_WAIT_L(0); PG8_MMA(0, 1, At, B1); PG8_BAR;
            PG8_LDA(At, 0, 1); PG8_STAGE(PG8_SA(0, 0), a2, voffA);
            PG8_BAR; PG8_WAIT_L(0); PG8_MMA(1, 0, At, B0); PG8_BAR; PG8_SCHED;
            PG8_STAGE(PG8_SB(0, 1), b2 + hstep, voffB);
            PG8_WAIT_V(6); PG8_BAR; PG8_MMA(1, 1, At, B1); PG8_BAR;
            PG8_LDB(B0, 1, 0); PG8_SCHED; PG8_LDA(At, 1, 0); PG8_STAGE(PG8_SA(0, 1), a2 + hstep, voffA);
            PG8_WAIT_L(8); PG8_BAR; PG8_WAIT_L(0); PG8_MMA(0, 0, At, B0); PG8_BAR; PG8_SCHED;
            PG8_LDB(B1, 1, 1); PG8_STAGE(PG8_SB(1, 0), b3, voffB);
            PG8_BAR; PG8_WAIT_L(0); PG8_MMA(0, 1, At, B1); PG8_BAR;
            PG8_LDA(At, 1, 1); PG8_STAGE(PG8_SA(1, 0), a3, voffA);
            PG8_BAR; PG8_WAIT_L(0); PG8_MMA(1, 0, At, B0); PG8_BAR; PG8_SCHED;
            PG8_STAGE(PG8_SB(1, 1), b3 + hstep, voffB);
            PG8_WAIT_V(6); PG8_BAR; PG8_MMA(1, 1, At, B1); PG8_BAR;
            }
        }
        if constexpr (ALIGN_EPI) { if (wr == 0) PG8_BAR; }
        if constexpr (!Epi::AFTER_DRAIN) {
            if constexpr (Epi::HAS_PREP) {
                f32x4 pr_[4]; if (has_next) E.prep_load(nxt.pm, tid, pr_);
                E(acc, cur, wr, wc, fr, fq);
                if (has_next) E.prep_store((ui + 1) & 1, tid, pr_);
            } else E(acc, cur, wr, wc, fr, fq);
            S.done(cur); }
        if (!has_next) break;
#pragma unroll
        for (int a = 0; a < 2; ++a)
#pragma unroll
            for (int b = 0; b < 2; ++b)
#pragma unroll
                for (int m = 0; m < 4; ++m)
#pragma unroll
                    for (int n = 0; n < 2; ++n) acc[a][b][m][n] = (f32x4){0.f, 0.f, 0.f, 0.f};
        cur = nxt; cur.par = (ui + 1) & 1; cA = nA; cB = nB; ++ui;
        if constexpr (ALIGN_EPI) { if (wr == 1) PG8_BAR; }
    }
    PG8_WAIT_V(0);
    if constexpr (!ALIGN_EPI) { if (wr == 0) PG8_BAR; }
    PG8_BAR;
    if constexpr (Epi::AFTER_DRAIN) { E.fused(acc, cur, wr, wc, fr, fq, lds, wid, lane); S.done(cur); }
#undef PG8_SA
#undef PG8_SB
#undef PG8_STAGE
#undef PG8_LDA
#undef PG8_LDB
#undef PG8_MMA
#undef PG8_WAIT_V
#undef PG8_WAIT_L
#undef PG8_BAR
#undef PG8_SCHED
}
}

#define LAS __attribute__((address_space(3)))
typedef unsigned short bf16_t;
typedef short bf16x8 __attribute__((ext_vector_type(8)));
typedef short s16x4 __attribute__((ext_vector_type(4)));
typedef float f32x4 __attribute__((ext_vector_type(4)));
typedef float f32x2 __attribute__((ext_vector_type(2)));
typedef float f32x16 __attribute__((ext_vector_type(16)));
typedef unsigned u32x4 __attribute__((ext_vector_type(4)));
typedef unsigned u32x2 __attribute__((ext_vector_type(2)));
typedef __bf16 bf16x2_t __attribute__((ext_vector_type(2)));

constexpr int BATCH = 4, SEQ = 4096, DM = 1024, DEPTH = 4, FF = 2816, MTOK = BATCH * SEQ, NIN = 5120, NGU = 2 * FF;
constexpr float LOG2E = 1.4426950408889634f;
constexpr float QSCALE = 0.125f * LOG2E;
constexpr int NWAVES = 8, NTHR = 512;

constexpr size_t MiB = 1u << 20;
constexpr size_t WS_SSQ = 1 * MiB;
constexpr size_t WS_W = 2 * MiB;
constexpr size_t LW_GU1 = 0, LW_D1 = 11 * MiB, LW_IN = LW_D1 + 5 * MiB + MiB / 2, LW_BR = LW_IN + 10 * MiB, LW_OUT = LW_BR + 2 * MiB,
                 LW_GU2 = LW_OUT + 2 * MiB, LW_D2 = LW_GU2 + 11 * MiB, LW_BYTES = LW_D2 + 5 * MiB + MiB / 2;
static_assert(LW_BYTES == 47 * MiB, "layer weight block");
constexpr size_t WS_XB = WS_W + DEPTH * LW_BYTES;
constexpr size_t WS_R = WS_XB + 32 * MiB;
constexpr size_t WS_ACT = WS_R;
constexpr size_t WS_Q = WS_R, WS_K = WS_Q + 16 * MiB, WS_VT = WS_K + 16 * MiB, WS_CB = WS_VT + 16 * MiB, WS_P = WS_CB + 16 * MiB,
                 WS_GA = WS_P + 16 * MiB, WS_GC = WS_GA + 32 * MiB, WS_AA = WS_GC + 32 * MiB, WS_END = WS_AA + 32 * MiB;
constexpr size_t WS_MG = WS_Q;
static_assert(WS_ACT + (size_t)MTOK * FF * 2 <= WS_END, "ACT inside the overlay");

__device__ __forceinline__ unsigned pk2bf(float lo, float hi) { f32x2 v = {lo, hi}; bf16x2_t b = __builtin_convertvector(v, bf16x2_t); return __builtin_bit_cast(unsigned, b); }
__device__ __forceinline__ float bflo(unsigned w) { return __uint_as_float(w << 16); }
__device__ __forceinline__ float bfhi(unsigned w) { return __uint_as_float(w & 0xffff0000u); }
__device__ __forceinline__ float fast_sigmoid(float v) { return __builtin_amdgcn_rcpf(1.0f + __builtin_amdgcn_exp2f(-v * LOG2E)); }
__device__ __forceinline__ int fresh_lane() { int l; asm volatile("v_mbcnt_lo_u32_b32 %0, -1, 0\n\tv_mbcnt_hi_u32_b32 %0, -1, %0" : "=v"(l)); return l; }
__device__ __forceinline__ float wave_sum(float v) {
#pragma unroll
    for (int o = 1; o < 64; o <<= 1) v += __shfl_xor(v, o);
    return v;
}
__device__ __forceinline__ float row_rstd_q(const float* ssq, int row, int fq) {
    const f32x4 a = *(const f32x4*)(ssq + (size_t)row * 16 + fq * 4);
    float t = (a[0] + a[1]) + (a[2] + a[3]);
    t += __shfl_xor(t, 16); t += __shfl_xor(t, 32);
    return __builtin_amdgcn_rsqf(t * (1.0f / 1024.0f) + 1e-6f);
}
__device__ __forceinline__ float row_rstd(const float* ssq, int row) {
    const f32x4* p = (const f32x4*)(ssq + (size_t)row * 16);
    const f32x4 a = p[0], b = p[1], c = p[2], d = p[3];
    const f32x4 s = (a + b) + (c + d);
    const float t = (s[0] + s[1]) + (s[2] + s[3]);
    return __builtin_amdgcn_rsqf(t * (1.0f / 1024.0f) + 1e-6f);
}

#define GAS __attribute__((address_space(1)))
namespace pg8 {
__device__ __forceinline__ void rstd8(float (&rs)[2][4], const float* ssq, int row0, int fq) {
    f32x4 a[2][4];
#pragma unroll
    for (int ai = 0; ai < 2; ++ai)
#pragma unroll
        for (int m = 0; m < 4; ++m) a[ai][m] = *(const GAS f32x4*)(ssq + (size_t)(row0 + ai * HALF + m * 16) * 16 + fq * 4);
#pragma unroll
    for (int ai = 0; ai < 2; ++ai)
#pragma unroll
        for (int m = 0; m < 4; ++m) {
            float t = (a[ai][m][0] + a[ai][m][1]) + (a[ai][m][2] + a[ai][m][3]);
            t += __shfl_xor(t, 16); t += __shfl_xor(t, 32);
            rs[ai][m] = __builtin_amdgcn_rsqf(t * (1.0f / 1024.0f) + 1e-6f);
        }
}
struct EpiGU {
    static constexpr bool PERM = true, AFTER_DRAIN = false, HAS_PREP = true;
    bf16_t* ACT; const float* ssq;
    PG8_LAS float* tab;
    __device__ __forceinline__ void prep_load(int pm, int tid, f32x4 (&r)[4]) const {
        if (tid < 256) { const GAS f32x4* p = (const GAS f32x4*)(ssq + (size_t)(pm * BM + tid) * 16); r[0] = p[0]; r[1] = p[1]; r[2] = p[2]; r[3] = p[3]; }
    }
    __device__ __forceinline__ void prep_store(int par, int tid, const f32x4 (&r)[4]) const {
        if (tid < 256) { const f32x4 q = (r[0] + r[1]) + (r[2] + r[3]); tab[par * 256 + tid] = __builtin_amdgcn_rsqf(((q[0] + q[1]) + (q[2] + q[3])) * (1.0f / 1024.0f) + 1e-6f); }
    }

    __device__ __forceinline__ void operator()(const f32x4 (&acc)[2][2][4][2], const Unit& u, int wr, int wc, int fr, int fq) const {
        const int row0 = u.pm * BM + wr * 64 + fr, col = u.pn * 128 + wc * 32 + 8 * fq;
        float rsv[2][4];
#pragma unroll
        for (int ai = 0; ai < 2; ++ai)
#pragma unroll
            for (int m = 0; m < 4; ++m) rsv[ai][m] = tab[u.par * 256 + ai * HALF + wr * 64 + m * 16 + fr];
#pragma unroll
        for (int ai = 0; ai < 2; ++ai)
#pragma unroll
            for (int m = 0; m < 4; ++m) {
                const int row = row0 + ai * HALF + m * 16; const float rs = rsv[ai][m];
                float o[8];
#pragma unroll
                for (int n = 0; n < 2; ++n)
#pragma unroll
                    for (int e = 0; e < 4; ++e) { const float g = acc[ai][0][m][n][e] * rs, up = acc[ai][1][m][n][e] * rs; o[n * 4 + e] = g * fast_sigmoid(g) * up; }
                u32x4 w; w.x = pk2bf(o[0], o[1]); w.y = pk2bf(o[2], o[3]); w.z = pk2bf(o[4], o[5]); w.w = pk2bf(o[6], o[7]);
                *(GAS u32x4*)(ACT + (size_t)row * FF + col) = w;
            }
    }
};
struct EpiRes {
    static constexpr bool PERM = false, AFTER_DRAIN = false, HAS_PREP = false;
    const float* Xin; float* X; bf16_t* XB; float* ssq; float scale;
    __device__ __forceinline__ void operator()(const f32x4 (&acc)[2][2][4][2], const Unit& u, int wr, int wc, int fr, int fq) const {
        const int row0 = u.pm * BM + wr * 64 + fr, col0 = u.pn * BM + wc * 32 + 4 * fq;
        f32x4 xv[2][2][2][2];
#define RES_LOAD(st, par) do { _Pragma("unroll") for (int q_ = 0; q_ < 2; ++q_) { const int row_ = row0 + ((st) >> 1) * HALF + (2 * ((st) & 1) + q_) * 16; \
            _Pragma("unroll") for (int bj_ = 0; bj_ < 2; ++bj_) _Pragma("unroll") for (int n_ = 0; n_ < 2; ++n_) \
                xv[par][q_][bj_][n_] = *(const GAS f32x4*)(Xin + (size_t)row_ * DM + col0 + bj_ * HALF + n_ * 16); } } while (0)
        RES_LOAD(0, 0);
#pragma unroll
        for (int st = 0; st < 4; ++st) {
            const int par = st & 1, ai = st >> 1;
            if (st + 1 < 4) { if (par) RES_LOAD(st + 1, 0); else RES_LOAD(st + 1, 1); }
#pragma unroll
            for (int q = 0; q < 2; ++q) {
                const int m = 2 * (st & 1) + q, row = row0 + ai * HALF + m * 16; float ss = 0.f;
                float* xr = X + (size_t)row * DM + col0; bf16_t* xb = XB + (size_t)row * DM + col0;
#pragma unroll
                for (int bj = 0; bj < 2; ++bj)
#pragma unroll
                    for (int n = 0; n < 2; ++n) {
                        const int off = bj * HALF + n * 16;
                        const f32x4 x = xv[par][q][bj][n] + acc[ai][bj][m][n] * scale;
                        *(GAS f32x4*)(xr + off) = x;
                        u32x2 w; w.x = pk2bf(x[0], x[1]); w.y = pk2bf(x[2], x[3]); *(GAS u32x2*)(xb + off) = w;
                        ss += (x[0] * x[0] + x[1] * x[1]) + (x[2] * x[2] + x[3] * x[3]);
                    }
                ss += __shfl_xor(ss, 16); ss += __shfl_xor(ss, 32);
                if (fq == 0) *(GAS float*)(ssq + (size_t)row * 16 + u.pn * 4 + wc) = ss;
            }
        }
#undef RES_LOAD
    }
};
struct EpiIn {
    static constexpr bool PERM = true, AFTER_DRAIN = false, HAS_PREP = true;
    bf16_t *Q, *K, *VT, *CB, *P, *GA, *GC; const float* ssq;
    PG8_LAS float* tab;
    __device__ __forceinline__ void prep_load(int pm, int tid, f32x4 (&r)[4]) const {
        if (tid < 256) { const GAS f32x4* p = (const GAS f32x4*)(ssq + (size_t)(pm * BM + tid) * 16); r[0] = p[0]; r[1] = p[1]; r[2] = p[2]; r[3] = p[3]; }
    }
    __device__ __forceinline__ void prep_store(int par, int tid, const f32x4 (&r)[4]) const {
        if (tid < 256) { const f32x4 q = (r[0] + r[1]) + (r[2] + r[3]); tab[par * 256 + tid] = __builtin_amdgcn_rsqf(((q[0] + q[1]) + (q[2] + q[3])) * (1.0f / 1024.0f) + 1e-6f); }
    }

    __device__ __forceinline__ void operator()(const f32x4 (&acc)[2][2][4][2], const Unit& u, int wr, int wc, int fr, int fq) const {
        const int row0 = u.pm * BM + wr * 64 + fr, c8 = wc * 32 + 8 * fq, pn = u.pn;
        float rsv[2][4];
#pragma unroll
        for (int ai = 0; ai < 2; ++ai)
#pragma unroll
            for (int m = 0; m < 4; ++m) rsv[ai][m] = tab[u.par * 256 + ai * HALF + wr * 64 + m * 16 + fr];
#pragma unroll
        for (int ai = 0; ai < 2; ++ai)
#pragma unroll
            for (int m = 0; m < 4; ++m) {
                const int row = row0 + ai * HALF + m * 16; const float rs = rsv[ai][m];
                float v[2][8];
#pragma unroll
                for (int bj = 0; bj < 2; ++bj)
#pragma unroll
                    for (int n = 0; n < 2; ++n)
#pragma unroll
                        for (int e = 0; e < 4; ++e) v[bj][n * 4 + e] = acc[ai][bj][m][n][e] * rs;
                if (pn >= 8 && pn < 12) {
                    u32x4 w; w.x = pk2bf(v[0][0] * v[1][0], v[0][1] * v[1][1]); w.y = pk2bf(v[0][2] * v[1][2], v[0][3] * v[1][3]);
                    w.z = pk2bf(v[0][4] * v[1][4], v[0][5] * v[1][5]); w.w = pk2bf(v[0][6] * v[1][6], v[0][7] * v[1][7]);
                    *(GAS u32x4*)(P + (size_t)row * 512 + (pn - 8) * 128 + c8) = w;
                } else if (pn == 4 || pn == 5) {
                    const int b = row >> 12, t0 = row & 4095, t = (t0 & ~15) | ((((t0 >> 3) & 1) | (((t0 >> 2) & 1) << 1)) << 2) | (t0 & 3);
#pragma unroll
                    for (int bj = 0; bj < 2; ++bj) {
                        const int h = (pn - 4) * 2 + bj;
                        GAS bf16_t* vt = (GAS bf16_t*)(VT + ((size_t)((b * 4 + h) * 128 + c8)) * SEQ + t);
#pragma unroll
                        for (int e = 0; e < 8; e += 2) { const unsigned w = pk2bf(v[bj][e], v[bj][e + 1]); vt[(size_t)e * SEQ] = (bf16_t)(w & 0xffffu); vt[(size_t)(e + 1) * SEQ] = (bf16_t)(w >> 16); }
                    }
                } else {
                    bf16_t* dst; int ld; float sc = 1.f; bool sig = false;
                    if (pn < 2) { dst = Q + pn * 256; ld = 512; sc = QSCALE; }
                    else if (pn < 4) { dst = K + (pn - 2) * 256; ld = 512; }
                    else if (pn < 8) { dst = CB + (pn - 6) * 256; ld = 512; }
                    else if (pn < 16) { dst = GA + (pn - 12) * 256; ld = 1024; sig = true; }
                    else { dst = GC + (pn - 16) * 256; ld = 1024; sig = true; }
#pragma unroll
                    for (int bj = 0; bj < 2; ++bj) {
                        float o[8];
#pragma unroll
                        for (int e = 0; e < 8; ++e) o[e] = sig ? fast_sigmoid(v[bj][e]) : v[bj][e] * sc;
                        u32x4 w; w.x = pk2bf(o[0], o[1]); w.y = pk2bf(o[2], o[3]); w.z = pk2bf(o[4], o[5]); w.w = pk2bf(o[6], o[7]);
                        *(GAS u32x4*)(dst + (size_t)row * ld + bj * HALF + c8) = w;
                    }
                }
            }
    }
};
struct EpiBr {
    static constexpr bool PERM = true, AFTER_DRAIN = false, HAS_PREP = false;
    const bf16_t* G; bf16_t* MG; int second;
    __device__ __forceinline__ void operator()(const f32x4 (&acc)[2][2][4][2], const Unit& u, int wr, int wc, int fr, int fq) const {
        const int row0 = u.pm * BM + wr * 64 + fr, col = u.pn * BM + wc * 32 + 8 * fq;
#pragma unroll
        for (int ai = 0; ai < 2; ++ai) {
            u32x4 gw[4][2], pw[4][2];
#pragma unroll
            for (int m = 0; m < 4; ++m)
#pragma unroll
                for (int bj = 0; bj < 2; ++bj) {
                    const size_t off = (size_t)(row0 + ai * HALF + m * 16) * DM + col + bj * HALF;
                    gw[m][bj] = *(const GAS u32x4*)(G + off);
                    pw[m][bj] = second ? *(const GAS u32x4*)(MG + off) : (u32x4){0u, 0u, 0u, 0u};
                }
#pragma unroll
            for (int m = 0; m < 4; ++m)
#pragma unroll
                for (int bj = 0; bj < 2; ++bj) {
                    const size_t off = (size_t)(row0 + ai * HALF + m * 16) * DM + col + bj * HALF;
                    const u32x4 g = gw[m][bj], p = pw[m][bj];
                    float o[8];
                    o[0] = bflo(g.x) * acc[ai][bj][m][0][0] + bflo(p.x); o[1] = bfhi(g.x) * acc[ai][bj][m][0][1] + bfhi(p.x);
                    o[2] = bflo(g.y) * acc[ai][bj][m][0][2] + bflo(p.y); o[3] = bfhi(g.y) * acc[ai][bj][m][0][3] + bfhi(p.y);
                    o[4] = bflo(g.z) * acc[ai][bj][m][1][0] + bflo(p.z); o[5] = bfhi(g.z) * acc[ai][bj][m][1][1] + bfhi(p.z);
                    o[6] = bflo(g.w) * acc[ai][bj][m][1][2] + bflo(p.w); o[7] = bfhi(g.w) * acc[ai][bj][m][1][3] + bfhi(p.w);
                    u32x4 w; w.x = pk2bf(o[0], o[1]); w.y = pk2bf(o[2], o[3]); w.z = pk2bf(o[4], o[5]); w.w = pk2bf(o[6], o[7]);
                    *(GAS u32x4*)(MG + off) = w;
                }
        }
    }
};
}

namespace att {
constexpr int STG = 32768, VOFS = 16384, OFF_LUT = 131072 + 512;
constexpr float THR = 8.0f;
__device__ __forceinline__ int crow(int r, int hi) { return (r & 3) + 8 * (r >> 2) + 4 * hi; }
#define MFMA32(a, b, c) __builtin_amdgcn_mfma_f32_32x32x16_bf16((a), (b), (c), 0, 0, 0)
#define ATT_SBAR() __builtin_amdgcn_sched_barrier(0)
#define ATT_EX2(x) __builtin_amdgcn_exp2f(x)
__device__ __forceinline__ float max3f(float a, float b, float c) { float r; asm("v_max3_f32 %0, %1, %2, %3" : "=v"(r) : "v"(a), "v"(b), "v"(c)); return r; }
__device__ __forceinline__ void glds16(const void* g, LAS unsigned char* l) { __builtin_amdgcn_global_load_lds((const unsigned*)g, (LAS unsigned*)l, 16, 0, 0); }

__device__ __forceinline__ void load_K(bf16x8 (&kf)[8], LAS const unsigned char* kbase, const int (&koff)[4]) {
#pragma unroll
    for (int j = 0; j < 4; ++j) { kf[2 * j] = *(LAS const bf16x8*)(kbase + koff[j]); kf[2 * j + 1] = *(LAS const bf16x8*)(kbase + koff[j] + 8192); }
}
__device__ __forceinline__ void compute_S(f32x16& B0, f32x16& B1, const bf16x8 (&kf)[8], const bf16x8 (&qf)[4],
                                          bool near, LAS const float* lut, int dbase, int hi) {
    if (near) {
        int dh = dbase - 4 * hi; asm volatile("" : "+v"(dh));
#pragma unroll
        for (int i = 0; i < 16; ++i) {
            const int d0 = dh - ((i & 3) + 8 * (i >> 2)), d1 = d0 - 32;
            const int c0 = d0 < 0 ? 0 : (d0 > 127 ? 127 : d0), c1 = d1 < 0 ? 0 : (d1 > 127 ? 127 : d1);
            const float l0 = lut[c0], l1 = lut[c1];
            B0[i] = d0 < 0 ? -1e30f : l0; B1[i] = d1 < 0 ? -1e30f : l1;
        }
    } else {
#pragma unroll
        for (int i = 0; i < 16; ++i) { B0[i] = 0.f; B1[i] = 0.f; }
    }
#pragma unroll
    for (int j = 0; j < 4; ++j) { B0 = MFMA32(kf[2 * j], qf[j], B0); B1 = MFMA32(kf[2 * j + 1], qf[j], B1); }
}

__device__ __forceinline__ void softmax_pv(f32x16& A0, f32x16& A1, f32x16 (&O)[4], float& mrun, f32x16& Lacc, bool first, LAS const unsigned char* vbase, const int (&voff)[4],
                                           bf16x8 (&kf)[8], LAS const unsigned char* knext, const int (&koff)[4], bool pre) {
    float mxa = max3f(A0[0], A0[1], A1[0]), mxb = max3f(A0[2], A0[3], A1[1]); mxa = max3f(mxa, A1[2], A1[3]);
#pragma unroll
    for (int i = 4; i < 16; i += 4) { mxa = max3f(mxa, A0[i], A0[i + 1]); mxb = max3f(mxb, A0[i + 2], A0[i + 3]); mxa = max3f(mxa, A1[i], A1[i + 1]); mxb = max3f(mxb, A1[i + 2], A1[i + 3]); }
    float mx = fmaxf(mxa, mxb);
    { auto rr = __builtin_amdgcn_permlane32_swap(__float_as_uint(mx), __float_as_uint(mx), false, false); mx = fmaxf(__uint_as_float(rr[0]), __uint_as_float(rr[1])); }
    const float rel = mx - mrun;
    const bool need = first ? (fabsf(mx) > THR) : (rel > THR);
    if (__builtin_amdgcn_ballot_w64(need) != 0ull) {
        const float delta = need ? rel : 0.f, f = ATT_EX2(-delta);
        mrun += delta; Lacc = Lacc * f;
#pragma unroll
        for (int d = 0; d < 4; ++d) O[d] = O[d] * f;
    }
    if (__builtin_amdgcn_ballot_w64(mrun != 0.f) != 0ull) {
#pragma unroll
        for (int i = 0; i < 16; ++i) { A0[i] -= mrun; A1[i] -= mrun; }
    }
    ATT_SBAR();
    u32x4 w[4]; bf16x8 vfr[16];
    const bf16x8 ones = {0x3F80, 0x3F80, 0x3F80, 0x3F80, 0x3F80, 0x3F80, 0x3F80, 0x3F80};
#define ATT_LDV(g) do { vfr[g] = *(LAS const bf16x8*)(vbase + voff[(g) >> 2] + ((g) & 3) * 4096); } while (0)
    ATT_LDV(0); ATT_LDV(1); ATT_LDV(2); ATT_LDV(3); ATT_LDV(4); ATT_LDV(5);
    {
        float x[8];
#pragma unroll
        for (int i = 0; i < 8; ++i) x[i] = ATT_EX2(A0[i]);
        w[0].x = pk2bf(x[0], x[1]); w[0].y = pk2bf(x[2], x[3]); w[0].z = pk2bf(x[4], x[5]); w[0].w = pk2bf(x[6], x[7]);
    }
    ATT_SBAR();
#pragma unroll
    for (int g = 0; g < 16; ++g) {
        const int s = g >> 2, d = g & 3;
        asm volatile("" : "+v"(vfr[g]), "+v"(A0), "+v"(A1));
        O[d] = MFMA32(vfr[g], __builtin_bit_cast(bf16x8, w[s]), O[d]);
        if (d == 0) Lacc = MFMA32(ones, __builtin_bit_cast(bf16x8, w[s]), Lacc);
        if (g + 6 < 16) ATT_LDV(g + 6);
        if (g >= 8 && pre) kf[g - 8] = *(LAS const bf16x8*)(knext + koff[(g - 8) >> 1] + ((g - 8) & 1) * 8192);
        if (s < 3) {
            const int idx = 8 * (s + 1) + 2 * d;
            const float a0 = idx < 16 ? A0[idx & 15] : A1[idx & 15], a1 = idx < 16 ? A0[(idx + 1) & 15] : A1[(idx + 1) & 15];
            const float x0 = ATT_EX2(a0), x1 = ATT_EX2(a1);
            unsigned wd = pk2bf(x0, x1);
            asm volatile("" : "+v"(wd));
            w[s + 1][d] = wd;
        }
        ATT_SBAR();
    }
#undef ATT_LDV
}

__device__ __forceinline__ void attn_phase(LAS unsigned char* lds, const bf16_t* Q, const bf16_t* K, const bf16_t* VT, bf16_t* AA, const float* rel_bias,
                                           float lam, int v2, int tid, int wid, int lane) {
    static constexpr unsigned char BUCKET[128] = {0, 1, 2, 3, 4, 5, 6, 7, 8, 9, 10, 11, 12, 13, 14, 15, 16, 16, 16, 17, 17, 18, 18, 18, 19, 19, 19, 20, 20, 20, 20, 21,
        21, 21, 21, 22, 22, 22, 22, 22, 23, 23, 23, 23, 23, 23, 24, 24, 24, 24, 24, 24, 25, 25, 25, 25, 25, 25, 25, 26, 26, 26, 26, 26,
        26, 26, 26, 27, 27, 27, 27, 27, 27, 27, 27, 27, 27, 28, 28, 28, 28, 28, 28, 28, 28, 28, 28, 29, 29, 29, 29, 29, 29, 29, 29, 29,
        29, 29, 29, 30, 30, 30, 30, 30, 30, 30, 30, 30, 30, 30, 30, 30, 30, 31, 31, 31, 31, 31, 31, 31, 31, 31, 31, 31, 31, 31, 31, 31};
    const int bh = v2 >> 5, jj = v2 & 31, b = bh >> 2, h = bh & 3;
    const int c = wid & 1, r0 = 2 * jj + ((wid >> 1) & 1), r = (wid >> 2) ? (127 - r0) : r0, slot = wid >> 1;
    const int ntw = (r >> 1) + 1, NT = ((127 - 2 * jj) >> 1) + 1;
    const int m = lane & 31, hi = lane >> 5;
    LAS float* lut = (LAS float*)(lds + OFF_LUT);
    { int t2 = tid; asm volatile("" : "+v"(t2)); if (t2 < 128) lut[t2] = (rel_bias[BUCKET[t2] * 4 + h] - rel_bias[31 * 4 + h]) * LOG2E; }
    const bf16_t* qrow = Q + (size_t)(b * SEQ + 32 * r + m) * 512 + h * 128 + c * 64 + 8 * hi;
    bf16x8 qf[4];
#pragma unroll
    for (int j = 0; j < 4; ++j) qf[j] = *(const bf16x8*)(qrow + 16 * j);
    int koff[4], voff[4];
#pragma unroll
    for (int j = 0; j < 4; ++j) koff[j] = m * 256 + (((c * 8 + 2 * j + hi) ^ (m & 15)) << 4);
#pragma unroll
    for (int q = 0; q < 4; ++q) voff[q] = VOFS + m * 128 + (((2 * q + hi) ^ ((m >> 1) & 7)) << 4);
    const int kR = 8 * wid + (lane >> 4), vD = 16 * wid + (lane >> 3);
    const bf16_t* ks0 = K + (size_t)(b * SEQ + kR) * 512 + h * 128 + (((lane & 15) ^ (kR & 15)) << 3);
    const bf16_t* ks1 = K + (size_t)(b * SEQ + kR + 4) * 512 + h * 128 + (((lane & 15) ^ ((kR + 4) & 15)) << 3);
    const bf16_t* vs0 = VT + ((size_t)bh * 128 + vD) * SEQ + (((lane & 7) ^ ((vD >> 1) & 7)) << 3);
    const bf16_t* vs1 = VT + ((size_t)bh * 128 + vD + 8) * SEQ + (((lane & 7) ^ (((vD + 8) >> 1) & 7)) << 3);
    const int kd0 = 8 * wid * 256, vd0 = VOFS + 16 * wid * 128;
#define ATT_DMA(t) do { LAS unsigned char* sb_ = lds + ((t) & 3) * STG; const size_t ko_ = (size_t)(t) * 64 * 512; const int vo_ = (t) * 64; \
        glds16(ks0 + ko_, sb_ + kd0); glds16(ks1 + ko_, sb_ + kd0 + 1024); glds16(vs0 + vo_, sb_ + vd0); glds16(vs1 + vo_, sb_ + vd0 + 1024); } while (0)
#define ATT_WAITBAR(n) do { asm volatile("s_waitcnt vmcnt(" #n ") lgkmcnt(0)" ::: "memory"); __builtin_amdgcn_s_barrier(); asm volatile("" ::: "memory"); } while (0)
    ATT_DMA(0); ATT_DMA(1); ATT_DMA(2);
    ATT_WAITBAR(4);
    f32x16 O[4], SA0, SA1;
#pragma unroll
    for (int d = 0; d < 4; ++d)
#pragma unroll
        for (int i = 0; i < 16; ++i) O[d][i] = 0.f;
    float mrun = 0.f; f32x16 Lacc;
#pragma unroll
    for (int i = 0; i < 16; ++i) Lacc[i] = 0.f;
    const int qd = 32 * r + m;
    bf16x8 kf[8];
    load_K(kf, lds, koff);
    for (int t = 0; t < NT; ++t) {
        if (t + 3 < NT) ATT_DMA(t + 3);
        if (t < ntw) {
            load_K(kf, lds + (t & 3) * STG, koff);
            compute_S(SA0, SA1, kf, qf, 32 * r - 64 * t < 176, lut, qd - 64 * t, hi);
            softmax_pv(SA0, SA1, O, mrun, Lacc, t == 0, lds + (t & 3) * STG, voff, kf, lds + ((t + 1) & 3) * STG, koff, false);
        }
        if (t + 3 < NT) ATT_WAITBAR(4); else ATT_WAITBAR(0);
    }
#undef ATT_STEP
#undef ATT_DMA
#undef ATT_WAITBAR
    const float lrun = Lacc[0];
    const float sc = c ? lam / lrun : 1.0f / lrun;
    LAS f32x4* ex = (LAS f32x4*)(lds + slot * 16384 + lane * 64);
    if (c) {
#pragma unroll
        for (int d = 0; d < 4; ++d)
#pragma unroll
            for (int g = 0; g < 4; ++g) ex[d * 256 + g] = (f32x4){O[d][4 * g] * sc, O[d][4 * g + 1] * sc, O[d][4 * g + 2] * sc, O[d][4 * g + 3] * sc};
    }
    __syncthreads();
    if (!c) {
        float ss = 0.f;
#pragma unroll
        for (int d = 0; d < 4; ++d)
#pragma unroll
            for (int g = 0; g < 4; ++g) {
                const f32x4 o2 = ex[d * 256 + g];
#pragma unroll
                for (int e = 0; e < 4; ++e) { const float o = O[d][4 * g + e] * sc - o2[e]; O[d][4 * g + e] = o; ss += o * o; }
            }
        ss += __shfl_xor(ss, 32);
        const float rn = __builtin_amdgcn_rsqf(ss * (1.0f / 128.0f) + 1e-5f);
        bf16_t* orow = AA + (size_t)(b * SEQ + 32 * r + m) * 512 + h * 128 + 4 * hi;
#pragma unroll
        for (int d = 0; d < 4; ++d)
#pragma unroll
            for (int g = 0; g < 4; ++g) {
                u32x2 w; w.x = pk2bf(O[d][4 * g] * rn, O[d][4 * g + 1] * rn); w.y = pk2bf(O[d][4 * g + 2] * rn, O[d][4 * g + 3] * rn);
                *(u32x2*)(orow + 32 * d + 8 * g) = w;
            }
    }
    __syncthreads();
}
}

#define XB_TMO      128
#define XB_XCNT(j)  (256  + 64 * (j))
#define XB_XSUB(j)  (1280 + 64 * (j))
#define XB_XGEN(j)  (2304 + 64 * (j))
#define XB_TOP      3328
#define XB_TOPGEN   3392
#define XCD_BAR_WORDS 3456
#define XB_SPIN_CAP (1u << 18)

__device__ __forceinline__ unsigned xb_ld(unsigned* p)              { return __hip_atomic_load(p, __ATOMIC_RELAXED, __HIP_MEMORY_SCOPE_AGENT); }
__device__ __forceinline__ unsigned xb_add(unsigned* p, unsigned v) { return __hip_atomic_fetch_add(p, v, __ATOMIC_RELAXED, __HIP_MEMORY_SCOPE_AGENT); }
__device__ __forceinline__ unsigned xb_xcc_id() { return (unsigned)__builtin_amdgcn_s_getreg((3 << 11) | 20) & 0xFu; }
#define XB_SPIN(cond, bar) do { unsigned _sp = 0; while (cond) { __builtin_amdgcn_s_sleep(1); \
    if ((++_sp & 255u) == 0u) { if (xb_ld(&(bar)[XB_TMO])) break; if (_sp > XB_SPIN_CAP) { atomicAdd(&(bar)[XB_TMO], 1u); break; } } } } while (0)

struct XcdBarrier {
    unsigned* bar; unsigned x;
    volatile LAS unsigned* st;
};

__device__ __forceinline__ XcdBarrier xcd_barrier_post(unsigned* bar, volatile LAS unsigned* st) {
    XcdBarrier b; b.bar = bar; b.x = xb_xcc_id(); b.st = st;
    if (threadIdx.x == 0) (void)xb_add(&bar[XB_XCNT(b.x)], 1u);
    return b;
}
__device__ __forceinline__ void xcd_barrier_complete(unsigned* bar, unsigned x, unsigned& nloc, unsigned& nx) {
    const unsigned G = gridDim.x * gridDim.y * gridDim.z;
    unsigned sum, cnt, mine, sp = 0u;
    for (;;) {
        sum = 0u; cnt = 0u; mine = 0u;
#pragma unroll
        for (unsigned j = 0; j < 16; ++j) { const unsigned c = xb_ld(&bar[XB_XCNT(j)]); sum += c; cnt += (c > 0u) ? 1u : 0u; mine = (j == x) ? c : mine; }
        if (sum == G) break;
        __builtin_amdgcn_s_sleep(1);
        if ((++sp & 255u) == 0u) { if (xb_ld(&bar[XB_TMO])) break; if (sp > XB_SPIN_CAP) { atomicAdd(&bar[XB_TMO], 1u); break; } }
    }
    nloc = mine > 0u ? mine : 1u; nx = cnt > 0u ? cnt : 1u;
}

__device__ __forceinline__ void xcd_barrier(const XcdBarrier& b) {
    asm volatile("s_waitcnt vmcnt(0)" ::: "memory");
    __syncthreads();
    if (threadIdx.x == 0) {
        unsigned* bar = b.bar;
        __builtin_amdgcn_s_waitcnt(0);
        unsigned nloc = b.st[0], nx = b.st[1];
        if (nloc == 0u) { xcd_barrier_complete(bar, b.x, nloc, nx); b.st[0] = nloc; b.st[1] = nx; }
        const unsigned old = xb_add(&bar[XB_XSUB(b.x)], 1u);
        const unsigned gen = old / nloc;
        if (old + 1u == (gen + 1u) * nloc) {
            __builtin_amdgcn_fence(__ATOMIC_RELEASE, "agent");
            asm volatile("s_waitcnt vmcnt(0)" ::: "memory");
            const unsigned og = xb_add(&bar[XB_TOP], 1u);
            const unsigned tg = og / nx;
            if (og + 1u == (tg + 1u) * nx) xb_add(&bar[XB_TOPGEN], 1u);
            else XB_SPIN(xb_ld(&bar[XB_TOPGEN]) == tg, bar);
            __builtin_amdgcn_fence(__ATOMIC_ACQUIRE, "agent");
            xb_add(&bar[XB_XGEN(b.x)], 1u);
            asm volatile("s_waitcnt vmcnt(0)" ::: "memory");
        } else {
            XB_SPIN(xb_ld(&bar[XB_XGEN(b.x)]) == gen, bar);
            __builtin_amdgcn_fence(__ATOMIC_ACQUIRE, "agent");
            asm volatile("s_waitcnt vmcnt(0)" ::: "memory");
        }
    }
    __syncthreads();
}

__device__ __forceinline__ void tr_item(const float* W, int K, int N, bf16_t* WT, int drow0, int k0, int n0, const float* gk, int gmask, float gfac, LAS float* scr, int lane) {
    float wv[32], sv[32];
#pragma unroll
    for (int i = 0; i < 32; ++i) {
        const int kk = 2 * i + (lane >> 5);
        wv[i] = __builtin_nontemporal_load(W + (size_t)(k0 + kk) * N + n0 + (lane & 31));
        sv[i] = gk ? gk[(k0 + kk) & gmask] * gfac : 1.0f;
    }
#pragma unroll
    for (int i = 0; i < 32; ++i) scr[(2 * i + (lane >> 5)) * 33 + (lane & 31)] = wv[i] * sv[i];
    asm volatile("s_waitcnt lgkmcnt(0)" ::: "memory");
    const int c = lane & 7;
#pragma unroll
    for (int j = 0; j < 4; ++j) {
        const int n = (lane >> 3) + 8 * j; const LAS float* s = scr + (8 * c) * 33 + n;
        u32x4 o; o.x = pk2bf(s[0 * 33], s[1 * 33]); o.y = pk2bf(s[2 * 33], s[3 * 33]); o.z = pk2bf(s[4 * 33], s[5 * 33]); o.w = pk2bf(s[6 * 33], s[7 * 33]);
        *(u32x4*)(WT + (size_t)(drow0 + n) * K + k0 + 8 * c) = o;
    }
    asm volatile("s_waitcnt lgkmcnt(0)" ::: "memory");
}
__device__ __forceinline__ float lambda_init(int l) { return 0.8f - 0.6f * __expf(-0.3f * (float)l); }

__device__ __forceinline__ int first_pn(int N, int G, int bx) { pg8::StaticOrder S; S.init(MTOK, N, G, bx); pg8::Unit u; u.pm = 0; u.pn = 0; (void)S.next(0, u); return u.pn; }
struct Args { const float* in[22]; float* out; unsigned char* ws; int ph_lo, ph_hi; };
constexpr int ITEMS_PER_LAYER = 12032;
constexpr int LDS_DYN = 132 * 1024;

__global__ void __launch_bounds__(NTHR, 2) fwd_kernel(Args a) {
    extern __shared__ __attribute__((aligned(16))) unsigned char lds_raw[];
    LAS unsigned char* lds = (LAS unsigned char*)lds_raw;
    cg::grid_group grid = cg::this_grid();
    const int tid = threadIdx.x, lane = tid & 63, wid = __builtin_amdgcn_readfirstlane(tid >> 6);
    const int G = gridDim.x, bx = blockIdx.x;
    const int vcu = (G % 8 == 0) ? (bx % 8) * (G / 8) + bx / 8 : bx;
    unsigned char* ws = a.ws;
    const int lo = a.ph_lo, hi = a.ph_hi;
    int pc = 0;
    volatile LAS unsigned* MISC = (volatile LAS unsigned*)(lds + 131072 + 64);
    if (tid < 2) MISC[tid] = 0u;
    __syncthreads();
    XcdBarrier bar = xcd_barrier_post((unsigned*)(ws + 0), MISC);
#define PH_ON() (lo <= pc && pc < hi)
#define PH_END() do { if (lo <= pc && pc + 1 < hi) { if (lo > 1000000) grid.sync(); else xcd_barrier(bar); } ++pc; } while (0)

    if (PH_ON()) {
        LAS float* scr = (LAS float*)(lds + wid * 16384);
        const int gw = vcu * NWAVES + wid, NGW = G * NWAVES;
        for (int it = gw; it < DEPTH * ITEMS_PER_LAYER; it += NGW) {
            const int l = it / ITEMS_PER_LAYER; int r = it % ITEMS_PER_LAYER;
            unsigned char* wl = ws + WS_W + (size_t)l * LW_BYTES;
            if (r < 2816 || (r >= 7808 && r < 10624)) {
                const int second = r >= 7808; if (second) r -= 7808;
                const int up = r >= 1408; if (up) r -= 1408;
                const int kb = r / 88, nb = r % 88, n0 = 32 * nb, drow = (n0 >> 7) * 256 + up * 128 + (n0 & 127);
                const float* W = a.in[second ? (up ? 19 : 18) : (up ? 3 : 2)] + (size_t)l * DM * FF;
                tr_item(W, DM, FF, (bf16_t*)(wl + (second ? LW_GU2 : LW_GU1)), drow, 64 * kb, n0, a.in[second ? 17 : 1] + l * DM, 1023, 1.0f, scr, lane);
            } else if (r < 4224 || r >= 10624) {
                const int second = r >= 10624; r -= second ? 10624 : 2816;
                const int kb = r / 32, nb = r % 32;
                tr_item(a.in[second ? 20 : 4] + (size_t)l * FF * DM, FF, DM, (bf16_t*)(wl + (second ? LW_D2 : LW_D1)), 32 * nb, 64 * kb, 32 * nb, nullptr, 0, 1.0f, scr, lane);
            } else if (r < 6784) {
                r -= 4224; const int kb = r / 160, nb = r % 160, n0 = 32 * nb; int drow = n0;
                if (n0 >= 2048 && n0 < 2560) { const int j = n0 - 2048; drow = 2048 + (j >> 7) * 256 + (j & 127); }
                else if (n0 >= 2560 && n0 < 3072) { const int j = n0 - 2560; drow = 2048 + (j >> 7) * 256 + 128 + (j & 127); }
                tr_item(a.in[6] + (size_t)l * DM * NIN, DM, NIN, (bf16_t*)(wl + LW_IN), drow, 64 * kb, n0, a.in[5] + l * DM, 1023, 1.0f, scr, lane);
            } else if (r < 7040) {
                r -= 6784; const int kb = r / 32, nb = r % 32;
                tr_item(a.in[14] + (size_t)l * 512 * DM, 512, DM, (bf16_t*)(wl + LW_BR), 32 * nb, 64 * kb, 32 * nb, a.in[11] + l * 128, 127, 1.0f - lambda_init(l), scr, lane);
            } else if (r < 7296) {
                r -= 7040; const int kb = r / 32, nb = r % 32;
                tr_item(a.in[15] + (size_t)l * 512 * DM, 512, DM, (bf16_t*)(wl + LW_BR), 1024 + 32 * nb, 64 * kb, 32 * nb, nullptr, 0, 1.0f, scr, lane);
            } else {
                r -= 7296; const int kb = r / 32, nb = r % 32;
                tr_item(a.in[16] + (size_t)l * DM * DM, DM, DM, (bf16_t*)(wl + LW_OUT), 32 * nb, 64 * kb, 32 * nb, nullptr, 0, 1.0f, scr, lane);
            }
        }
        const float* x = a.in[0]; float* X = a.out; float* SSQ = (float*)(ws + WS_SSQ); bf16_t* XB = (bf16_t*)(ws + WS_XB);
        for (int mrow = gw; mrow < MTOK; mrow += NGW) {
            const f32x4* xr = (const f32x4*)(x + (size_t)mrow * DM) + lane;
            unsigned long long* xb8 = (unsigned long long*)(XB + (size_t)mrow * DM) + lane;
            float s = 0.f;
#pragma unroll
            for (int j = 0; j < 4; ++j) {
                const f32x4 v = xr[64 * j]; s += (v[0] * v[0] + v[1] * v[1]) + (v[2] * v[2] + v[3] * v[3]);
                xb8[64 * j] = (unsigned long long)pk2bf(v[0], v[1]) | ((unsigned long long)pk2bf(v[2], v[3]) << 32);
            }
            s = wave_sum(s);
            if (lane < 16) SSQ[(size_t)mrow * 16 + lane] = lane == 0 ? s : 0.f;
        }
    }
    PH_END();

#pragma unroll 1
    for (int f = 0; f < 2 * DEPTH; ++f) {
        const int l = f >> 1; const bool second = f & 1;
        unsigned char* wsl = a.ws; float* X = a.out; asm volatile("" : "+s"(wsl), "+s"(X));
        unsigned char* wl = wsl + WS_W + (size_t)l * LW_BYTES;
        float* SSQ = (float*)(wsl + WS_SSQ);
        bf16_t* XB = (bf16_t*)(wsl + WS_XB);
        bf16_t* ACT = (bf16_t*)(wsl + WS_ACT);
        bf16_t *Qb = (bf16_t*)(wsl + WS_Q), *Kb = (bf16_t*)(wsl + WS_K), *VTb = (bf16_t*)(wsl + WS_VT), *CBb = (bf16_t*)(wsl + WS_CB), *Pb = (bf16_t*)(wsl + WS_P),
               *GAb = (bf16_t*)(wsl + WS_GA), *GCb = (bf16_t*)(wsl + WS_GC), *AAb = (bf16_t*)(wsl + WS_AA), *MGb = (bf16_t*)(wsl + WS_MG);
        if (PH_ON()) {
            const int lane_l = fresh_lane(), tl = wid * 64 + lane_l;
            pg8::Gemm g{XB, (const bf16_t*)(wl + (second ? LW_GU2 : LW_GU1)), MTOK, NGU, DM}; pg8::StaticOrder S; S.init(MTOK, NGU, G, bx);
            pg8::EpiGU E{ACT, SSQ, (LAS float*)(lds + 132096)};
            const bf16_t* wd_ = (const bf16_t*)(wl + (second ? LW_D2 : LW_D1));
            pg8::gemm_phase<pg8::EpiGU, pg8::StaticOrder, true, true>(lds, g, S, E, tl, wd_ + (size_t)first_pn(DM, G, bx) * 256 * FF, FF, false, f > 0);
        }
        PH_END();
        if (PH_ON()) {
            const int lane_l = fresh_lane(), tl = wid * 64 + lane_l;
            pg8::Gemm g{ACT, (const bf16_t*)(wl + (second ? LW_D2 : LW_D1)), MTOK, DM, FF}; pg8::StaticOrder S; S.init(MTOK, DM, G, bx);
            pg8::EpiRes E{f == 0 ? a.in[0] : (const float*)X, X, XB, SSQ, 0.5f};
            const bf16_t* nb_ = !second ? (const bf16_t*)(wl + LW_IN) + (size_t)first_pn(NIN, G, bx) * 256 * DM
                              : (l + 1 < DEPTH ? (const bf16_t*)(wl + LW_BYTES + LW_GU1) + (size_t)first_pn(NGU, G, bx) * 256 * DM : (const bf16_t*)nullptr);
            pg8::gemm_phase<pg8::EpiRes, pg8::StaticOrder, true, true>(lds, g, S, E, tl, nb_, DM, true, true);
        }
        PH_END();
        if (second) continue;
        if (PH_ON()) {
            const int lane_l = fresh_lane(), tl = wid * 64 + lane_l;
            pg8::Gemm g{XB, (const bf16_t*)(wl + LW_IN), MTOK, NIN, DM}; pg8::StaticOrder S; S.init(MTOK, NIN, G, bx);
            pg8::EpiIn E{Qb, Kb, VTb, CBb, Pb, GAb, GCb, SSQ, (LAS float*)(lds + 132096)};
            pg8::gemm_phase<pg8::EpiIn, pg8::StaticOrder, true, true>(lds, g, S, E, tl, nullptr, 0, false, true);
        }
        PH_END();
        if (PH_ON()) {
            const int lane_l = fresh_lane(), tl = wid * 64 + lane_l;
            const float* cw = a.in[13] + (size_t)l * 3 * 512;
            bf16_t* AC = AAb + (size_t)MTOK * 512;
            for (int idx = bx * NTHR + tl; idx < MTOK * 64; idx += G * NTHR) {
                const int row = idx >> 6, c8 = (idx & 63) * 8, t = row & (SEQ - 1);
                const u32x4 z = {0u, 0u, 0u, 0u};
                const u32x4 p0 = *(const u32x4*)(Pb + (size_t)row * 512 + c8);
                const u32x4 p1 = t >= 1 ? *(const u32x4*)(Pb + (size_t)(row - 1) * 512 + c8) : z;
                const u32x4 p2 = t >= 2 ? *(const u32x4*)(Pb + (size_t)(row - 2) * 512 + c8) : z;
                const u32x4 cb = *(const u32x4*)(CBb + (size_t)row * 512 + c8);
                float o[8];
#pragma unroll
                for (int e = 0; e < 4; ++e) {
                    const float w0a = cw[c8 + 2 * e], w0b = cw[c8 + 2 * e + 1], w1a = cw[512 + c8 + 2 * e], w1b = cw[512 + c8 + 2 * e + 1], w2a = cw[1024 + c8 + 2 * e], w2b = cw[1024 + c8 + 2 * e + 1];
                    o[2 * e] = bflo(cb[e]) * (w0a * bflo(p2[e]) + w1a * bflo(p1[e]) + w2a * bflo(p0[e]));
                    o[2 * e + 1] = bfhi(cb[e]) * (w0b * bfhi(p2[e]) + w1b * bfhi(p1[e]) + w2b * bfhi(p0[e]));
                }
                u32x4 w; w.x = pk2bf(o[0], o[1]); w.y = pk2bf(o[2], o[3]); w.z = pk2bf(o[4], o[5]); w.w = pk2bf(o[6], o[7]);
                *(u32x4*)(AC + (size_t)row * 512 + c8) = w;
            }
            const float la = wave_sum(a.in[7][l * 64 + lane_l] * a.in[8][l * 64 + lane_l]), lb = wave_sum(a.in[9][l * 64 + lane_l] * a.in[10][l * 64 + lane_l]);
            const float lam = __builtin_bit_cast(float, __builtin_amdgcn_readfirstlane(__builtin_bit_cast(int, __expf(la) - __expf(lb) + lambda_init(l))));
#ifndef NO_ATT
            #pragma unroll 1
            for (int u2 = 0; u2 < 2; ++u2)
#pragma unroll 1
                for (int v = vcu; v < 256; v += G) att::attn_phase(lds, Qb, Kb, VTb, AAb, a.in[12], lam, (2 * (v >> 5) + u2) * 32 + (u2 ? 31 - (v & 31) : (v & 31)), tl, wid, lane_l);
#endif
        }
        PH_END();
        if (PH_ON()) {
            const int lane_l = fresh_lane(), tl = wid * 64 + lane_l;
#pragma unroll 1
            for (int gsel = 0; gsel < 2; ++gsel) {
                pg8::Gemm g{AAb + (size_t)gsel * MTOK * 512, (const bf16_t*)(wl + LW_BR) + (size_t)gsel * 1024 * 512, MTOK, DM, 512}; pg8::StaticOrder S; S.init(MTOK, DM, G, bx);
                pg8::EpiBr E{gsel ? GCb : GAb, MGb, gsel};
                const bf16_t* nb_ = gsel == 0 ? (const bf16_t*)(wl + LW_BR) + (size_t)1024 * 512 + (size_t)first_pn(DM, G, bx) * 256 * 512
                                              : (const bf16_t*)(wl + LW_OUT) + (size_t)first_pn(DM, G, bx) * 256 * DM;
                pg8::gemm_phase<pg8::EpiBr, pg8::StaticOrder, true, true>(lds, g, S, E, tl, nb_, gsel == 0 ? 512 : DM, gsel == 0, gsel == 1);
            }
        }
        PH_END();
        if (PH_ON()) {
            const int lane_l = fresh_lane(), tl = wid * 64 + lane_l;
            pg8::Gemm g{MGb, (const bf16_t*)(wl + LW_OUT), MTOK, DM, DM}; pg8::StaticOrder S; S.init(MTOK, DM, G, bx);
            pg8::EpiRes E{X, X, XB, SSQ, 1.0f};
            pg8::gemm_phase<pg8::EpiRes, pg8::StaticOrder, true, true>(lds, g, S, E, tl, (const bf16_t*)(wl + LW_GU2) + (size_t)first_pn(NGU, G, bx) * 256 * DM, DM, true, true);
        }
        PH_END();
    }
    if (PH_ON()) {
        const int gw = vcu * NWAVES + wid, NGW = G * NWAVES; const int lane = fresh_lane();
        const f32x4* gf = (const f32x4*)a.in[21] + lane; float* X = a.out;
        for (int mrow = gw; mrow < MTOK; mrow += NGW) {
            f32x4* xr = (f32x4*)(X + (size_t)mrow * DM) + lane;
            f32x4 v[4]; float s = 0.f;
#pragma unroll
            for (int j = 0; j < 4; ++j) { v[j] = xr[64 * j]; s += (v[j][0] * v[j][0] + v[j][1] * v[j][1]) + (v[j][2] * v[j][2] + v[j][3] * v[j][3]); }
            const float rstd = 1.0f / sqrtf(wave_sum(s) * (1.0f / DM) + 1e-6f);
#pragma unroll
            for (int j = 0; j < 4; ++j) xr[64 * j] = v[j] * rstd * gf[64 * j];
        }
    }
#undef PH_ON
#undef PH_END
}

constexpr int N_PHASES = 1 + DEPTH * 8 + 1;

extern "C" void kernel_launch(void* const* d_in, const int* in_sizes, int n_in, void* d_out, int out_size, void* d_ws, size_t ws_size, hipStream_t stream) {
    static int grid = 0;
    if (grid == 0) {
        if (n_in != 22 || in_sizes[0] != MTOK * DM || out_size != MTOK * DM || ws_size < WS_END) {
            fprintf(stderr, "kernel_launch: unexpected shapes (n_in %d, in0 %d, out %d, ws %zu < %zu)\n", n_in, n_in > 0 ? in_sizes[0] : -1, out_size, ws_size, (size_t)WS_END);
            grid = -1; return;
        }
        int dev = 0, cus = 0, per_cu = 0;
        (void)hipGetDevice(&dev);
        (void)hipDeviceGetAttribute(&cus, hipDeviceAttributeMultiprocessorCount, dev);
        (void)hipFuncSetAttribute((const void*)fwd_kernel, hipFuncAttributeMaxDynamicSharedMemorySize, LDS_DYN);
        (void)hipOccupancyMaxActiveBlocksPerMultiprocessor(&per_cu, (const void*)fwd_kernel, NTHR, LDS_DYN);
        (void)hipGetLastError();
        if (cus <= 0) cus = 256;
        grid = cus;
        if (per_cu < 1) fprintf(stderr, "kernel_launch: occupancy query says %d blocks per CU\n", per_cu);
    }
    if (grid < 0) return;
    (void)hipMemsetAsync(d_ws, 0, 16384, stream);
    Args a{};
    for (int i = 0; i < 22; ++i) a.in[i] = (const float*)d_in[i];
    a.out = (float*)d_out; a.ws = (unsigned char*)d_ws; a.ph_lo = 0; a.ph_hi = N_PHASES;
    void* args[] = {&a};
    hipError_t e = hipLaunchCooperativeKernel((const void*)fwd_kernel, dim3(grid), dim3(NTHR), args, LDS_DYN, stream);
    if (e != hipSuccess) fprintf(stderr, "kernel_launch: cooperative launch failed: %s (grid %d)\n", hipGetErrorString(e), grid);
}
```

```cpp
#include <hip/hip_runtime.h>
#include <hip/hip_cooperative_groups.h>
#include <cstdio>
#include <cstdint>
namespace cg = cooperative_groups;
namespace pg8 {
#define PG8_LAS __attribute__((address_space(3)))
typedef unsigned short bf16_t;
typedef short bf16x8 __attribute__((ext_vector_type(8)));
typedef float f32x4 __attribute__((ext_vector_type(4)));
typedef unsigned u32x4 __attribute__((ext_vector_type(4)));
constexpr int BM = 256, BK = 64, HALF = 128, HTB = HALF * BK * 2  , STAGE_BYTES = 8 * HTB, NXCD = 8, WGM = 4;

__host__ __device__ __forceinline__ int lds_byte(int r, int c) { const int st = (r >> 4) * 2 + (c >> 5), rr = r & 15, cc = c & 31, ob = rr * 64 + cc * 2; return st * 1024 + (ob ^ (((ob >> 9) & 1) << 5)); }
__host__ __device__ __forceinline__ void stage_rc(int b, int& R, int& C) { const int st = b / 1024, sb = b % 1024, swz = sb ^ (((sb >> 9) & 1) << 5); R = (st >> 1) * 16 + swz / 64; C = (st & 1) * 32 + (swz % 64) / 2; }
__host__ __device__ __forceinline__ int perm32(int rho) { const int n = rho >> 4, i = rho & 15; return 8 * (i >> 2) + 4 * n + (i & 3); }

struct Unit { int pm, pn, par; };
struct Gemm { const bf16_t* A; const bf16_t* Bt; int M, N, K; };

struct StaticOrder {
    int nM, nN, nwg, G, c;
    __host__ __device__ void init(int M, int N, int G_, int c_) { nM = M / BM; nN = N / BM; nwg = nM * nN; G = G_; c = c_; }
    __host__ __device__ bool next(int i, Unit& u) const {
        const long L = (long)i * G + c; if (L >= nwg) return false;
        int wgid = (int)L; { const int q = nwg / NXCD, r = nwg % NXCD, xcd = wgid % NXCD, off = wgid / NXCD; wgid = (xcd < r ? xcd * (q + 1) : r * (q + 1) + (xcd - r) * q) + off; }
        const int nig = WGM * nN, gid = wgid / nig, fm = gid * WGM, gsz = (nM - fm) < WGM ? (nM - fm) : WGM;
        u.pm = fm + ((wgid % nig) % gsz); u.pn = (wgid % nig) / gsz; return true;
    }
    __device__ __forceinline__ void a_ready(const Unit&) const {}
    __device__ __forceinline__ void done(const Unit&) const {}
};

__device__ __forceinline__ unsigned cvt_pk_bf16(float lo, float hi) { unsigned r; asm volatile("v_cvt_pk_bf16_f32 %0, %1, %2" : "=v"(r) : "v"(lo), "v"(hi)); return r; }
typedef float f32x2 __attribute__((ext_vector_type(2)));
template <class Epi, class Sched, bool ALIGN_EPI = false, bool SP2 = false>
__device__ __forceinline__ void gemm_phase(PG8_LAS unsigned char* lds, const Gemm g, const Sched& S, const Epi& E, const int tid,
                                           const bf16_t* nbB = nullptr, int nbK = 0, bool nbPerm = false, bool bpre = false) {
    const int wid = __builtin_amdgcn_readfirstlane(tid >> 6), lane = tid & 63, wr = wid >> 2, wc = wid & 3, fr = lane & 15, fq = lane >> 4;
    const int K = g.K, nt = K / BK;
    unsigned voffA[2], voffB[2];
#pragma unroll
    for (int i = 0; i < 2; ++i) { int R, C; stage_rc(tid * 16 + i * 8192, R, C); const int Rb = Epi::PERM ? ((R & ~31) + perm32(R & 31)) : R;
        voffA[i] = (unsigned)(R * K + C) * 2u; voffB[i] = (unsigned)(Rb * K + C) * 2u; }
    const size_t kstep = (size_t)(BK * 2);
    const size_t hstep = (size_t)HALF * K * 2;
    const size_t tstep = 2 * hstep;
    const unsigned ldsw = (unsigned)wid * 1024u;
    const int aoff = lds_byte(wr * 64 + fr, fq * 8), boff = lds_byte(wc * 32 + fr, fq * 8);
#define PG8_SA(b, h) (((b) * 2 + (h)) * HTB)
#define PG8_SB(b, h) ((4 + (b) * 2 + (h)) * HTB)
#define PG8_STAGE(bufoff, gbase, voff) do { _Pragma("unroll") for (int _i = 0; _i < 2; ++_i) \
        __builtin_amdgcn_global_load_lds((const unsigned*)((const char*)(gbase) + (voff)[_i]), (PG8_LAS unsigned*)(lds + (bufoff) + ldsw + _i * 8192), 16, 0, 0); } while (0)
#define PG8_LDA(dst, b, h) do { _Pragma("unroll") for (int m = 0; m < 4; ++m) _Pragma("unroll") for (int k = 0; k < 2; ++k) dst[m][k] = *(const PG8_LAS bf16x8*)(lds + PG8_SA(b, h) + aoff + m * 2048 + k * 1024); } while (0)
#define PG8_LDB(dst, b, h) do { _Pragma("unroll") for (int n = 0; n < 2; ++n) _Pragma("unroll") for (int k = 0; k < 2; ++k) dst[n][k] = *(const PG8_LAS bf16x8*)(lds + PG8_SB(b, h) + boff + n * 2048 + k * 1024); } while (0)
#define PG8_MMA(ai, bj, At, Bt) do { __builtin_amdgcn_s_setprio(1); _Pragma("unroll") for (int m = 0; m < 4; ++m) _Pragma("unroll") for (int n = 0; n < 2; ++n) _Pragma("unroll") for (int k = 0; k < 2; ++k) \
        acc[ai][bj][m][n] = __builtin_amdgcn_mfma_f32_16x16x32_bf16(Bt[n][k], At[m][k], acc[ai][bj][m][n], 0, 0, 0); __builtin_amdgcn_s_setprio(0); } while (0)
#define PG8_WAIT_V(n) asm volatile("s_waitcnt vmcnt(" #n ")" ::: "memory")
#define PG8_WAIT_L(n) asm volatile("s_waitcnt lgkmcnt(" #n ")" ::: "memory")
#define PG8_BAR __builtin_amdgcn_s_barrier()
#define PG8_SCHED __builtin_amdgcn_sched_barrier(0)
    Unit cur, nxt; int ui = 0;
    if (!S.next(0, cur)) return;
    cur.par = 0;
    if constexpr (Epi::HAS_PREP) { f32x4 pr_[4]; E.prep_load(cur.pm, tid, pr_); E.prep_store(0, tid, pr_); }
    f32x4 acc[2][2][4][2];
#pragma unroll
    for (int a = 0; a < 2; ++a)
#pragma unroll
        for (int b = 0; b < 2; ++b)
#pragma unroll
            for (int m = 0; m < 4; ++m)
#pragma unroll
                for (int n = 0; n < 2; ++n) acc[a][b][m][n] = (f32x4){0.f, 0.f, 0.f, 0.f};
    bf16x8 At[4][2], B0[2][2], B1[2][2];
    const char* cA = (const char*)g.A + (size_t)cur.pm * tstep; const char* cB = (const char*)g.Bt + (size_t)cur.pn * tstep;
    S.a_ready(cur);
    if constexpr (SP2) {
        if (bpre) {
            PG8_STAGE(PG8_SA(0, 0), cA, voffA); PG8_STAGE(PG8_SA(0, 1), cA + hstep, voffA);
            if (wr == 1) PG8_BAR;
            PG8_WAIT_V(2); PG8_BAR;
            PG8_STAGE(PG8_SA(1, 0), cA + kstep, voffA);
            PG8_WAIT_V(2); PG8_BAR;
        } else {
        PG8_STAGE(PG8_SB(0, 0), cB, voffB); PG8_STAGE(PG8_SB(0, 1), cB + hstep, voffB); PG8_STAGE(PG8_SA(0, 0), cA, voffA); PG8_STAGE(PG8_SA(0, 1), cA + hstep, voffA);
        if (wr == 1) PG8_BAR;
        PG8_WAIT_V(2); PG8_BAR;
        PG8_STAGE(PG8_SB(1, 0), cB + kstep, voffB); PG8_STAGE(PG8_SA(1, 0), cA + kstep, voffA); PG8_STAGE(PG8_SB(1, 1), cB + hstep + kstep, voffB);
        PG8_WAIT_V(6); PG8_BAR;
        }
    } else {
        PG8_STAGE(PG8_SB(0, 0), cB, voffB); PG8_STAGE(PG8_SA(0, 0), cA, voffA); PG8_STAGE(PG8_SB(0, 1), cB + hstep, voffB); PG8_STAGE(PG8_SA(0, 1), cA + hstep, voffA);
        if (wr == 1) PG8_BAR;
        PG8_WAIT_V(4); PG8_BAR;
        PG8_STAGE(PG8_SB(1, 0), cB + kstep, voffB); PG8_STAGE(PG8_SA(1, 0), cA + kstep, voffA); PG8_STAGE(PG8_SB(1, 1), cB + hstep + kstep, voffB);
        PG8_WAIT_V(6); PG8_BAR;
    }
    for (;;) {
        const bool has_next = S.next(ui + 1, nxt);
        const char* nA = has_next ? (const char*)g.A + (size_t)nxt.pm * tstep : cA; const char* nB = has_next ? (const char*)g.Bt + (size_t)nxt.pn * tstep : (nbB ? (const char*)nbB : cB);
        for (int t = 0; t < nt; t += 2) {
            const bool last = (t == nt - 2);
            const char* a1 = cA + (size_t)(t + 1) * kstep;
            const char* a2 = last ? nA : cA + (size_t)(t + 2) * kstep; const char* b2 = last ? nB : cB + (size_t)(t + 2) * kstep;
            const char* a3 = a2 + kstep; const char* b3 = b2 + kstep;
            unsigned vBn[2] = {voffB[0], voffB[1]}; size_t hB = hstep;
            if (last && !has_next && nbB) {
#pragma unroll
                for (int i = 0; i < 2; ++i) { int R, C; stage_rc(tid * 16 + i * 8192, R, C); const int Rb = nbPerm ? ((R & ~31) + perm32(R & 31)) : R; vBn[i] = (unsigned)(Rb * nbK + C) * 2u; }
                hB = (size_t)HALF * nbK * 2;
            }
            if (last && has_next) S.a_ready(nxt);
            if constexpr (SP2) {
            PG8_LDB(B0, 0, 0); PG8_LDB(B1, 0, 1); PG8_SCHED; PG8_LDA(At, 0, 0); PG8_STAGE(PG8_SA(1, 1), a1 + hstep, voffA);
            PG8_WAIT_V(8); PG8_WAIT_L(0); PG8_BAR; PG8_MMA(0, 0, At, B0); PG8_MMA(0, 1, At, B1); PG8_BAR; PG8_SCHED;
            PG8_LDA(At, 0, 1); PG8_STAGE(PG8_SB(0, 0), b2, vBn); PG8_STAGE(PG8_SB(0, 1), b2 + hB, vBn); PG8_STAGE(PG8_SA(0, 0), a2, voffA);
            PG8_WAIT_V(8); PG8_WAIT_L(0); PG8_BAR; PG8_MMA(1, 0, At, B0); PG8_MMA(1, 1, At, B1); PG8_BAR; PG8_SCHED;
            PG8_LDB(B0, 1, 0); PG8_LDB(B1, 1, 1); PG8_SCHED; PG8_LDA(At, 1, 0); PG8_STAGE(PG8_SA(0, 1), a2 + hstep, voffA);
            PG8_WAIT_V(8); PG8_WAIT_L(0); PG8_BAR; PG8_MMA(0, 0, At, B0); PG8_MMA(0, 1, At, B1); PG8_BAR; PG8_SCHED;
            PG8_LDA(At, 1, 1); PG8_STAGE(PG8_SB(1, 0), b3, vBn); PG8_STAGE(PG8_SB(1, 1), b3 + hB, vBn); PG8_STAGE(PG8_SA(1, 0), a3, voffA);
            PG8_WAIT_V(8); PG8_WAIT_L(0); PG8_BAR; PG8_MMA(1, 0, At, B0); PG8_MMA(1, 1, At, B1); PG8_BAR; PG8_SCHED;
            } else {
            PG8_LDB(B0, 0, 0); PG8_SCHED; PG8_LDA(At, 0, 0); PG8_STAGE(PG8_SA(1, 1), a1 + hstep, voffA);
            PG8_WAIT_L(8); PG8_BAR; PG8_WAIT_L(0); PG8_MMA(0, 0, At, B0); PG8_BAR; PG8_SCHED;
            PG8_LDB(B1, 0, 1); PG8_STAGE(PG8_SB(0, 0), b2, voffB);
            PG8_BAR; PG8_WAIT_L(0); PG8_MMA(0, 1, At, B1); PG8_BAR;
            PG8_LDA(At, 0, 1); PG8_STAGE(PG8_SA(0, 0), a2, voffA);
            PG8_BAR; PG8_WAIT_L(0); PG8_MMA(1, 0, At, B0); PG8_BAR; PG8_SCHED;
            PG8_STAGE(PG8_SB(0, 1), b2 + hstep, voffB);
            PG8_WAIT_V(6); PG8_BAR; PG8_MMA(1, 1, At, B1); PG8_BAR;
            PG8_LDB(B0, 1, 0); PG8_SCHED; PG8_LDA(At, 1, 0); PG8_STAGE(PG8_SA(0, 1), a2 + hstep, voffA);
            PG8_WAIT_L(8); PG8_BAR; PG8_WAIT_L(0); PG8_MMA(0, 0, At, B0); PG8_BAR; PG8_SCHED;
            PG8_LDB(B1, 1, 1); PG8_STAGE(PG8_SB(1, 0), b3, voffB);
            PG8_BAR; PG8_WAIT_L(0); PG8_MMA(0, 1, At, B1); PG8_BAR;
            PG8_LDA(At, 1, 1); PG8_STAGE(PG8_SA(1, 0), a3, voffA);
            PG8_BAR; PG8_WAIT_L(0); PG8_MMA(1, 0, At, B0); PG8_BAR; PG8_SCHED;
            PG8_STAGE(PG8_SB(1, 1), b3 + hstep, voffB);
            PG8_WAIT_V(6); PG8_BAR; PG8_MMA(1, 1, At, B1); PG8_BAR;
            }
        }
        if constexpr (ALIGN_EPI) { if (wr == 0) PG8_BAR; }
        if constexpr (!Epi::AFTER_DRAIN) {
            if constexpr (Epi::HAS_PREP) {
                f32x4 pr_[4]; if (has_next) E.prep_load(nxt.pm, tid, pr_);
                E(acc, cur, wr, wc, fr, fq);
                if (has_next) E.prep_store((ui + 1) & 1, tid, pr_);
            } else E(acc, cur, wr, wc, fr, fq);
            S.done(cur); }
        if (!has_next) break;
#pragma unroll
        for (int a = 0; a < 2; ++a)
#pragma unroll
            for (int b = 0; b < 2; ++b)
#pragma unroll
                for (int m = 0; m < 4; ++m)
#pragma unroll
                    for (int n = 0; n < 2; ++n) acc[a][b][m][n] = (f32x4){0.f, 0.f, 0.f, 0.f};
        cur = nxt; cur.par = (ui + 1) & 1; cA = nA; cB = nB; ++ui;
        if constexpr (ALIGN_EPI) { if (wr == 1) PG8_BAR; }
    }
    PG8_WAIT_V(0);
    if constexpr (!ALIGN_EPI) { if (wr == 0) PG8_BAR; }
    PG8_BAR;
    if constexpr (Epi::AFTER_DRAIN) { E.fused(acc, cur, wr, wc, fr, fq, lds, wid, lane); S.done(cur); }
#undef PG8_SA
#undef PG8_SB
#undef PG8_STAGE
#undef PG8_LDA
#undef PG8_LDB
#undef PG8_MMA
#undef PG8_WAIT_V
#undef PG8_WAIT_L
#undef PG8_BAR
#undef PG8_SCHED
}
}

#define LAS __attribute__((address_space(3)))
typedef unsigned short bf16_t;
typedef short bf16x8 __attribute__((ext_vector_type(8)));
typedef short s16x4 __attribute__((ext_vector_type(4)));
typedef float f32x4 __attribute__((ext_vector_type(4)));
typedef float f32x2 __attribute__((ext_vector_type(2)));
typedef float f32x16 __attribute__((ext_vector_type(16)));
typedef unsigned u32x4 __attribute__((ext_vector_type(4)));
typedef unsigned u32x2 __attribute__((ext_vector_type(2)));
typedef __bf16 bf16x2_t __attribute__((ext_vector_type(2)));

constexpr int BATCH = 4, SEQ = 4096, DM = 1024, DEPTH = 4, FF = 2816, MTOK = BATCH * SEQ, NIN = 5120, NGU = 2 * FF;
constexpr float LOG2E = 1.4426950408889634f;
constexpr float QSCALE = 0.125f * LOG2E;
constexpr int NWAVES = 8, NTHR = 512;

constexpr size_t MiB = 1u << 20;
constexpr size_t WS_SSQ = 1 * MiB;
constexpr size_t WS_W = 2 * MiB;
constexpr size_t LW_GU1 = 0, LW_D1 = 11 * MiB, LW_IN = LW_D1 + 5 * MiB + MiB / 2, LW_BR = LW_IN + 10 * MiB, LW_OUT = LW_BR + 2 * MiB,
                 LW_GU2 = LW_OUT + 2 * MiB, LW_D2 = LW_GU2 + 11 * MiB, LW_BYTES = LW_D2 + 5 * MiB + MiB / 2;
static_assert(LW_BYTES == 47 * MiB, "layer weight block");
constexpr size_t WS_XB = WS_W + DEPTH * LW_BYTES;
constexpr size_t WS_R = WS_XB + 32 * MiB;
constexpr size_t WS_ACT = WS_R;
constexpr size_t WS_Q = WS_R, WS_K = WS_Q + 16 * MiB, WS_VT = WS_K + 16 * MiB, WS_CB = WS_VT + 16 * MiB, WS_P = WS_CB + 16 * MiB,
                 WS_GA = WS_P + 16 * MiB, WS_GC = WS_GA + 32 * MiB, WS_AA = WS_GC + 32 * MiB, WS_END = WS_AA + 32 * MiB;
constexpr size_t WS_MG = WS_Q;
static_assert(WS_ACT + (size_t)MTOK * FF * 2 <= WS_END, "ACT inside the overlay");

__device__ __forceinline__ unsigned pk2bf(float lo, float hi) { f32x2 v = {lo, hi}; bf16x2_t b = __builtin_convertvector(v, bf16x2_t); return __builtin_bit_cast(unsigned, b); }
__device__ __forceinline__ float bflo(unsigned w) { return __uint_as_float(w << 16); }
__device__ __forceinline__ float bfhi(unsigned w) { return __uint_as_float(w & 0xffff0000u); }
__device__ __forceinline__ float fast_sigmoid(float v) { return __builtin_amdgcn_rcpf(1.0f + __builtin_amdgcn_exp2f(-v * LOG2E)); }
__device__ __forceinline__ int fresh_lane() { int l; asm volatile("v_mbcnt_lo_u32_b32 %0, -1, 0\n\tv_mbcnt_hi_u32_b32 %0, -1, %0" : "=v"(l)); return l; }
__device__ __forceinline__ float wave_sum(float v) {
#pragma unroll
    for (int o = 1; o < 64; o <<= 1) v += __shfl_xor(v, o);
    return v;
}
__device__ __forceinline__ float row_rstd_q(const float* ssq, int row, int fq) {
    const f32x4 a = *(const f32x4*)(ssq + (size_t)row * 16 + fq * 4);
    float t = (a[0] + a[1]) + (a[2] + a[3]);
    t += __shfl_xor(t, 16); t += __shfl_xor(t, 32);
    return __builtin_amdgcn_rsqf(t * (1.0f / 1024.0f) + 1e-6f);
}
__device__ __forceinline__ float row_rstd(const float* ssq, int row) {
    const f32x4* p = (const f32x4*)(ssq + (size_t)row * 16);
    const f32x4 a = p[0], b = p[1], c = p[2], d = p[3];
    const f32x4 s = (a + b) + (c + d);
    const float t = (s[0] + s[1]) + (s[2] + s[3]);
    return __builtin_amdgcn_rsqf(t * (1.0f / 1024.0f) + 1e-6f);
}

#define GAS __attribute__((address_space(1)))
namespace pg8 {
__device__ __forceinline__ void rstd8(float (&rs)[2][4], const float* ssq, int row0, int fq) {
    f32x4 a[2][4];
#pragma unroll
    for (int ai = 0; ai < 2; ++ai)
#pragma unroll
        for (int m = 0; m < 4; ++m) a[ai][m] = *(const GAS f32x4*)(ssq + (size_t)(row0 + ai * HALF + m * 16) * 16 + fq * 4);
#pragma unroll
    for (int ai = 0; ai < 2; ++ai)
#pragma unroll
        for (int m = 0; m < 4; ++m) {
            float t = (a[ai][m][0] + a[ai][m][1]) + (a[ai][m][2] + a[ai][m][3]);
            t += __shfl_xor(t, 16); t += __shfl_xor(t, 32);
            rs[ai][m] = __builtin_amdgcn_rsqf(t * (1.0f / 1024.0f) + 1e-6f);
        }
}
struct EpiGU {
    static constexpr bool PERM = true, AFTER_DRAIN = false, HAS_PREP = true;
    bf16_t* ACT; const float* ssq;
    PG8_LAS float* tab;
    __device__ __forceinline__ void prep_load(int pm, int tid, f32x4 (&r)[4]) const {
        if (tid < 256) { const GAS f32x4* p = (const GAS f32x4*)(ssq + (size_t)(pm * BM + tid) * 16); r[0] = p[0]; r[1] = p[1]; r[2] = p[2]; r[3] = p[3]; }
    }
    __device__ __forceinline__ void prep_store(int par, int tid, const f32x4 (&r)[4]) const {
        if (tid < 256) { const f32x4 q = (r[0] + r[1]) + (r[2] + r[3]); tab[par * 256 + tid] = __builtin_amdgcn_rsqf(((q[0] + q[1]) + (q[2] + q[3])) * (1.0f / 1024.0f) + 1e-6f); }
    }

    __device__ __forceinline__ void operator()(const f32x4 (&acc)[2][2][4][2], const Unit& u, int wr, int wc, int fr, int fq) const {
        const int row0 = u.pm * BM + wr * 64 + fr, col = u.pn * 128 + wc * 32 + 8 * fq;
        float rsv[2][4];
#pragma unroll
        for (int ai = 0; ai < 2; ++ai)
#pragma unroll
            for (int m = 0; m < 4; ++m) rsv[ai][m] = tab[u.par * 256 + ai * HALF + wr * 64 + m * 16 + fr];
#pragma unroll
        for (int ai = 0; ai < 2; ++ai)
#pragma unroll
            for (int m = 0; m < 4; ++m) {
                const int row = row0 + ai * HALF + m * 16; const float rs = rsv[ai][m];
                float o[8];
#pragma unroll
                for (int n = 0; n < 2; ++n)
#pragma unroll
                    for (int e = 0; e < 4; ++e) { const float g = acc[ai][0][m][n][e] * rs, up = acc[ai][1][m][n][e] * rs; o[n * 4 + e] = g * fast_sigmoid(g) * up; }
                u32x4 w; w.x = pk2bf(o[0], o[1]); w.y = pk2bf(o[2], o[3]); w.z = pk2bf(o[4], o[5]); w.w = pk2bf(o[6], o[7]);
                *(GAS u32x4*)(ACT + (size_t)row * FF + col) = w;
            }
    }
};
struct EpiRes {
    static constexpr bool PERM = false, AFTER_DRAIN = false, HAS_PREP = false;
    const float* Xin; float* X; bf16_t* XB; float* ssq; float scale;
    __device__ __forceinline__ void operator()(const f32x4 (&acc)[2][2][4][2], const Unit& u, int wr, int wc, int fr, int fq) const {
        const int row0 = u.pm * BM + wr * 64 + fr, col0 = u.pn * BM + wc * 32 + 4 * fq;
        f32x4 xv[2][2][2][2];
#define RES_LOAD(st, par) do { _Pragma("unroll") for (int q_ = 0; q_ < 2; ++q_) { const int row_ = row0 + ((st) >> 1) * HALF + (2 * ((st) & 1) + q_) * 16; \
            _Pragma("unroll") for (int bj_ = 0; bj_ < 2; ++bj_) _Pragma("unroll") for (int n_ = 0; n_ < 2; ++n_) \
                xv[par][q_][bj_][n_] = *(const GAS f32x4*)(Xin + (size_t)row_ * DM + col0 + bj_ * HALF + n_ * 16); } } while (0)
        RES_LOAD(0, 0);
#pragma unroll
        for (int st = 0; st < 4; ++st) {
            const int par = st & 1, ai = st >> 1;
            if (st + 1 < 4) { if (par) RES_LOAD(st + 1, 0); else RES_LOAD(st + 1, 1); }
#pragma unroll
            for (int q = 0; q < 2; ++q) {
                const int m = 2 * (st & 1) + q, row = row0 + ai * HALF + m * 16; float ss = 0.f;
                float* xr = X + (size_t)row * DM + col0; bf16_t* xb = XB + (size_t)row * DM + col0;
#pragma unroll
                for (int bj = 0; bj < 2; ++bj)
#pragma unroll
                    for (int n = 0; n < 2; ++n) {
                        const int off = bj * HALF + n * 16;
                        const f32x4 x = xv[par][q][bj][n] + acc[ai][bj][m][n] * scale;
                        *(GAS f32x4*)(xr + off) = x;
                        u32x2 w; w.x = pk2bf(x[0], x[1]); w.y = pk2bf(x[2], x[3]); *(GAS u32x2*)(xb + off) = w;
                        ss += (x[0] * x[0] + x[1] * x[1]) + (x[2] * x[2] + x[3] * x[3]);
                    }
                ss += __shfl_xor(ss, 16); ss += __shfl_xor(ss, 32);
                if (fq == 0) *(GAS float*)(ssq + (size_t)row * 16 + u.pn * 4 + wc) = ss;
            }
        }
#undef RES_LOAD
    }
};
struct EpiIn {
    static constexpr bool PERM = true, AFTER_DRAIN = false, HAS_PREP = true;
    bf16_t *Q, *K, *VT, *CB, *P, *GA, *GC; const float* ssq;
    PG8_LAS float* tab;
    __device__ __forceinline__ void prep_load(int pm, int tid, f32x4 (&r)[4]) const {
        if (tid < 256) { const GAS f32x4* p = (const GAS f32x4*)(ssq + (size_t)(pm * BM + tid) * 16); r[0] = p[0]; r[1] = p[1]; r[2] = p[2]; r[3] = p[3]; }
    }
    __device__ __forceinline__ void prep_store(int par, int tid, const f32x4 (&r)[4]) const {
        if (tid < 256) { const f32x4 q = (r[0] + r[1]) + (r[2] + r[3]); tab[par * 256 + tid] = __builtin_amdgcn_rsqf(((q[0] + q[1]) + (q[2] + q[3])) * (1.0f / 1024.0f) + 1e-6f); }
    }

    __device__ __forceinline__ void operator()(const f32x4 (&acc)[2][2][4][2], const Unit& u, int wr, int wc, int fr, int fq) const {
        const int row0 = u.pm * BM + wr * 64 + fr, c8 = wc * 32 + 8 * fq, pn = u.pn;
        float rsv[2][4];
#pragma unroll
        for (int ai = 0; ai < 2; ++ai)
#pragma unroll
            for (int m = 0; m < 4; ++m) rsv[ai][m] = tab[u.par * 256 + ai * HALF + wr * 64 + m * 16 + fr];
#pragma unroll
        for (int ai = 0; ai < 2; ++ai)
#pragma unroll
            for (int m = 0; m < 4; ++m) {
                const int row = row0 + ai * HALF + m * 16; const float rs = rsv[ai][m];
                float v[2][8];
#pragma unroll
                for (int bj = 0; bj < 2; ++bj)
#pragma unroll
                    for (int n = 0; n < 2; ++n)
#pragma unroll
                        for (int e = 0; e < 4; ++e) v[bj][n * 4 + e] = acc[ai][bj][m][n][e] * rs;
                if (pn >= 8 && pn < 12) {
                    u32x4 w; w.x = pk2bf(v[0][0] * v[1][0], v[0][1] * v[1][1]); w.y = pk2bf(v[0][2] * v[1][2], v[0][3] * v[1][3]);
                    w.z = pk2bf(v[0][4] * v[1][4], v[0][5] * v[1][5]); w.w = pk2bf(v[0][6] * v[1][6], v[0][7] * v[1][7]);
                    *(GAS u32x4*)(P + (size_t)row * 512 + (pn - 8) * 128 + c8) = w;
                } else if (pn == 4 || pn == 5) {
                    const int b = row >> 12, t0 = row & 4095, t = (t0 & ~15) | ((((t0 >> 3) & 1) | (((t0 >> 2) & 1) << 1)) << 2) | (t0 & 3);
#pragma unroll
                    for (int bj = 0; bj < 2; ++bj) {
                        const int h = (pn - 4) * 2 + bj;
                        GAS bf16_t* vt = (GAS bf16_t*)(VT + ((size_t)((b * 4 + h) * 128 + c8)) * SEQ + t);
#pragma unroll
                        for (int e = 0; e < 8; e += 2) { const unsigned w = pk2bf(v[bj][e], v[bj][e + 1]); vt[(size_t)e * SEQ] = (bf16_t)(w & 0xffffu); vt[(size_t)(e + 1) * SEQ] = (bf16_t)(w >> 16); }
                    }
                } else {
                    bf16_t* dst; int ld; float sc = 1.f; bool sig = false;
                    if (pn < 2) { dst = Q + pn * 256; ld = 512; sc = QSCALE; }
                    else if (pn < 4) { dst = K + (pn - 2) * 256; ld = 512; }
                    else if (pn < 8) { dst = CB + (pn - 6) * 256; ld = 512; }
                    else if (pn < 16) { dst = GA + (pn - 12) * 256; ld = 1024; sig = true; }
                    else { dst = GC + (pn - 16) * 256; ld = 1024; sig = true; }
#pragma unroll
                    for (int bj = 0; bj < 2; ++bj) {
                        float o[8];
#pragma unroll
                        for (int e = 0; e < 8; ++e) o[e] = sig ? fast_sigmoid(v[bj][e]) : v[bj][e] * sc;
                        u32x4 w; w.x = pk2bf(o[0], o[1]); w.y = pk2bf(o[2], o[3]); w.z = pk2bf(o[4], o[5]); w.w = pk2bf(o[6], o[7]);
                        *(GAS u32x4*)(dst + (size_t)row * ld + bj * HALF + c8) = w;
                    }
                }
            }
    }
};
struct EpiBr {
    static constexpr bool PERM = true, AFTER_DRAIN = false, HAS_PREP = false;
    const bf16_t* G; bf16_t* MG; int second;
    __device__ __forceinline__ void operator()(const f32x4 (&acc)[2][2][4][2], const Unit& u, int wr, int wc, int fr, int fq) const {
        const int row0 = u.pm * BM + wr * 64 + fr, col = u.pn * BM + wc * 32 + 8 * fq;
#pragma unroll
        for (int ai = 0; ai < 2; ++ai) {
            u32x4 gw[4][2], pw[4][2];
#pragma unroll
            for (int m = 0; m < 4; ++m)
#pragma unroll
                for (int bj = 0; bj < 2; ++bj) {
                    const size_t off = (size_t)(row0 + ai * HALF + m * 16) * DM + col + bj * HALF;
                    gw[m][bj] = *(const GAS u32x4*)(G + off);
                    pw[m][bj] = second ? *(const GAS u32x4*)(MG + off) : (u32x4){0u, 0u, 0u, 0u};
                }
#pragma unroll
            for (int m = 0; m < 4; ++m)
#pragma unroll
                for (int bj = 0; bj < 2; ++bj) {
                    const size_t off = (size_t)(row0 + ai * HALF + m * 16) * DM + col + bj * HALF;
                    const u32x4 g = gw[m][bj], p = pw[m][bj];
                    float o[8];
                    o[0] = bflo(g.x) * acc[ai][bj][m][0][0] + bflo(p.x); o[1] = bfhi(g.x) * acc[ai][bj][m][0][1] + bfhi(p.x);
                    o[2] = bflo(g.y) * acc[ai][bj][m][0][2] + bflo(p.y); o[3] = bfhi(g.y) * acc[ai][bj][m][0][3] + bfhi(p.y);
                    o[4] = bflo(g.z) * acc[ai][bj][m][1][0] + bflo(p.z); o[5] = bfhi(g.z) * acc[ai][bj][m][1][1] + bfhi(p.z);
                    o[6] = bflo(g.w) * acc[ai][bj][m][1][2] + bflo(p.w); o[7] = bfhi(g.w) * acc[ai][bj][m][1][3] + bfhi(p.w);
                    u32x4 w; w.x = pk2bf(o[0], o[1]); w.y = pk2bf(o[2], o[3]); w.z = pk2bf(o[4], o[5]); w.w = pk2bf(o[6], o[7]);
                    *(GAS u32x4*)(MG + off) = w;
                }
        }
    }
};
}

namespace att {
constexpr int STG = 32768, VOFS = 16384, OFF_LUT = 131072 + 512;
constexpr float THR = 8.0f;
__device__ __forceinline__ int crow(int r, int hi) { return (r & 3) + 8 * (r >> 2) + 4 * hi; }
#define MFMA32(a, b, c) __builtin_amdgcn_mfma_f32_32x32x16_bf16((a), (b), (c), 0, 0, 0)
#define ATT_SBAR() __builtin_amdgcn_sched_barrier(0)
#define ATT_EX2(x) __builtin_amdgcn_exp2f(x)
__device__ __forceinline__ float max3f(float a, float b, float c) { float r; asm("v_max3_f32 %0, %1, %2, %3" : "=v"(r) : "v"(a), "v"(b), "v"(c)); return r; }
__device__ __forceinline__ void glds16(const void* g, LAS unsigned char* l) { __builtin_amdgcn_global_load_lds((const unsigned*)g, (LAS unsigned*)l, 16, 0, 0); }

__device__ __forceinline__ void load_K(bf16x8 (&kf)[8], LAS const unsigned char* kbase, const int (&koff)[4]) {
#pragma unroll
    for (int j = 0; j < 4; ++j) { kf[2 * j] = *(LAS const bf16x8*)(kbase + koff[j]); kf[2 * j + 1] = *(LAS const bf16x8*)(kbase + koff[j] + 8192); }
}
__device__ __forceinline__ void compute_S(f32x16& B0, f32x16& B1, const bf16x8 (&kf)[8], const bf16x8 (&qf)[4],
                                          bool near, LAS const float* lut, int dbase, int hi) {
    if (near) {
        int dh = dbase - 4 * hi; asm volatile("" : "+v"(dh));
#pragma unroll
        for (int i = 0; i < 16; ++i) {
            const int d0 = dh - ((i & 3) + 8 * (i >> 2)), d1 = d0 - 32;
            const int c0 = d0 < 0 ? 0 : (d0 > 127 ? 127 : d0), c1 = d1 < 0 ? 0 : (d1 > 127 ? 127 : d1);
            const float l0 = lut[c0], l1 = lut[c1];
            B0[i] = d0 < 0 ? -1e30f : l0; B1[i] = d1 < 0 ? -1e30f : l1;
        }
    } else {
#pragma unroll
        for (int i = 0; i < 16; ++i) { B0[i] = 0.f; B1[i] = 0.f; }
    }
#pragma unroll
    for (int j = 0; j < 4; ++j) { B0 = MFMA32(kf[2 * j], qf[j], B0); B1 = MFMA32(kf[2 * j + 1], qf[j], B1); }
}

__device__ __forceinline__ void softmax_pv(f32x16& A0, f32x16& A1, f32x16 (&O)[4], float& mrun, f32x16& Lacc, bool first, LAS const unsigned char* vbase, const int (&voff)[4],
                                           bf16x8 (&kf)[8], LAS const unsigned char* knext, const int (&koff)[4], bool pre) {
    float mxa = max3f(A0[0], A0[1], A1[0]), mxb = max3f(A0[2], A0[3], A1[1]); mxa = max3f(mxa, A1[2], A1[3]);
#pragma unroll
    for (int i = 4; i < 16; i += 4) { mxa = max3f(mxa, A0[i], A0[i + 1]); mxb = max3f(mxb, A0[i + 2], A0[i + 3]); mxa = max3f(mxa, A1[i], A1[i + 1]); mxb = max3f(mxb, A1[i + 2], A1[i + 3]); }
    float mx = fmaxf(mxa, mxb);
    { auto rr = __builtin_amdgcn_permlane32_swap(__float_as_uint(mx), __float_as_uint(mx), false, false); mx = fmaxf(__uint_as_float(rr[0]), __uint_as_float(rr[1])); }
    const float rel = mx - mrun;
    const bool need = first ? (fabsf(mx) > THR) : (rel > THR);
    if (__builtin_amdgcn_ballot_w64(need) != 0ull) {
        const float delta = need ? rel : 0.f, f = ATT_EX2(-delta);
        mrun += delta; Lacc = Lacc * f;
#pragma unroll
        for (int d = 0; d < 4; ++d) O[d] = O[d] * f;
    }
    if (__builtin_amdgcn_ballot_w64(mrun != 0.f) != 0ull) {
#pragma unroll
        for (int i = 0; i < 16; ++i) { A0[i] -= mrun; A1[i] -= mrun; }
    }
    ATT_SBAR();
    u32x4 w[4]; bf16x8 vfr[16];
    const bf16x8 ones = {0x3F80, 0x3F80, 0x3F80, 0x3F80, 0x3F80, 0x3F80, 0x3F80, 0x3F80};
#define ATT_LDV(g) do { vfr[g] = *(LAS const bf16x8*)(vbase + voff[(g) >> 2] + ((g) & 3) * 4096); } while (0)
    ATT_LDV(0); ATT_LDV(1); ATT_LDV(2); ATT_LDV(3); ATT_LDV(4); ATT_LDV(5);
    {
        float x[8];
#pragma unroll
        for (int i = 0; i < 8; ++i) x[i] = ATT_EX2(A0[i]);
        w[0].x = pk2bf(x[0], x[1]); w[0].y = pk2bf(x[2], x[3]); w[0].z = pk2bf(x[4], x[5]); w[0].w = pk2bf(x[6], x[7]);
    }
    ATT_SBAR();
#pragma unroll
    for (int g = 0; g < 16; ++g) {
        const int s = g >> 2, d = g & 3;
        asm volatile("" : "+v"(vfr[g]), "+v"(A0), "+v"(A1));
        O[d] = MFMA32(vfr[g], __builtin_bit_cast(bf16x8, w[s]), O[d]);
        if (d == 0) Lacc = MFMA32(ones, __builtin_bit_cast(bf16x8, w[s]), Lacc);
        if (g + 6 < 16) ATT_LDV(g + 6);
        if (g >= 8 && pre) kf[g - 8] = *(LAS const bf16x8*)(knext + koff[(g - 8) >> 1] + ((g - 8) & 1) * 8192);
        if (s < 3) {
            const int idx = 8 * (s + 1) + 2 * d;
            const float a0 = idx < 16 ? A0[idx & 15] : A1[idx & 15], a1 = idx < 16 ? A0[(idx + 1) & 15] : A1[(idx + 1) & 15];
            const float x0 = ATT_EX2(a0), x1 = ATT_EX2(a1);
            unsigned wd = pk2bf(x0, x1);
            asm volatile("" : "+v"(wd));
            w[s + 1][d] = wd;
        }
        ATT_SBAR();
    }
#undef ATT_LDV
}

__device__ __forceinline__ void attn_phase(LAS unsigned char* lds, const bf16_t* Q, const bf16_t* K, const bf16_t* VT, bf16_t* AA, const float* rel_bias,
                                           float lam, int v2, int tid, int wid, int lane) {
    static constexpr unsigned char BUCKET[128] = {0, 1, 2, 3, 4, 5, 6, 7, 8, 9, 10, 11, 12, 13, 14, 15, 16, 16, 16, 17, 17, 18, 18, 18, 19, 19, 19, 20, 20, 20, 20, 21,
        21, 21, 21, 22, 22, 22, 22, 22, 23, 23, 23, 23, 23, 23, 24, 24, 24, 24, 24, 24, 25, 25, 25, 25, 25, 25, 25, 26, 26, 26, 26, 26,
        26, 26, 26, 27, 27, 27, 27, 27, 27, 27, 27, 27, 27, 28, 28, 28, 28, 28, 28, 28, 28, 28, 28, 29, 29, 29, 29, 29, 29, 29, 29, 29,
        29, 29, 29, 30, 30, 30, 30, 30, 30, 30, 30, 30, 30, 30, 30, 30, 30, 31, 31, 31, 31, 31, 31, 31, 31, 31, 31, 31, 31, 31, 31, 31};
    const int bh = v2 >> 5, jj = v2 & 31, b = bh >> 2, h = bh & 3;
    const int c = wid & 1, r0 = 2 * jj + ((wid >> 1) & 1), r = (wid >> 2) ? (127 - r0) : r0, slot = wid >> 1;
    const int ntw = (r >> 1) + 1, NT = ((127 - 2 * jj) >> 1) + 1;
    const int m = lane & 31, hi = lane >> 5;
    LAS float* lut = (LAS float*)(lds + OFF_LUT);
    { int t2 = tid; asm volatile("" : "+v"(t2)); if (t2 < 128) lut[t2] = (rel_bias[BUCKET[t2] * 4 + h] - rel_bias[31 * 4 + h]) * LOG2E; }
    const bf16_t* qrow = Q + (size_t)(b * SEQ + 32 * r + m) * 512 + h * 128 + c * 64 + 8 * hi;
    bf16x8 qf[4];
#pragma unroll
    for (int j = 0; j < 4; ++j) qf[j] = *(const bf16x8*)(qrow + 16 * j);
    int koff[4], voff[4];
#pragma unroll
    for (int j = 0; j < 4; ++j) koff[j] = m * 256 + (((c * 8 + 2 * j + hi) ^ (m & 15)) << 4);
#pragma unroll
    for (int q = 0; q < 4; ++q) voff[q] = VOFS + m * 128 + (((2 * q + hi) ^ ((m >> 1) & 7)) << 4);
    const int kR = 8 * wid + (lane >> 4), vD = 16 * wid + (lane >> 3);
    const bf16_t* ks0 = K + (size_t)(b * SEQ + kR) * 512 + h * 128 + (((lane & 15) ^ (kR & 15)) << 3);
    const bf16_t* ks1 = K + (size_t)(b * SEQ + kR + 4) * 512 + h * 128 + (((lane & 15) ^ ((kR + 4) & 15)) << 3);
    const bf16_t* vs0 = VT + ((size_t)bh * 128 + vD) * SEQ + (((lane & 7) ^ ((vD >> 1) & 7)) << 3);
    const bf16_t* vs1 = VT + ((size_t)bh * 128 + vD + 8) * SEQ + (((lane & 7) ^ (((vD + 8) >> 1) & 7)) << 3);
    const int kd0 = 8 * wid * 256, vd0 = VOFS + 16 * wid * 128;
#define ATT_DMA(t) do { LAS unsigned char* sb_ = lds + ((t) & 3) * STG; const size_t ko_ = (size_t)(t) * 64 * 512; const int vo_ = (t) * 64; \
        glds16(ks0 + ko_, sb_ + kd0); glds16(ks1 + ko_, sb_ + kd0 + 1024); glds16(vs0 + vo_, sb_ + vd0); glds16(vs1 + vo_, sb_ + vd0 + 1024); } while (0)
#define ATT_WAITBAR(n) do { asm volatile("s_waitcnt vmcnt(" #n ") lgkmcnt(0)" ::: "memory"); __builtin_amdgcn_s_barrier(); asm volatile("" ::: "memory"); } while (0)
    ATT_DMA(0); ATT_DMA(1); ATT_DMA(2);
    ATT_WAITBAR(4);
    f32x16 O[4], SA0, SA1;
#pragma unroll
    for (int d = 0; d < 4; ++d)
#pragma unroll
        for (int i = 0; i < 16; ++i) O[d][i] = 0.f;
    float mrun = 0.f; f32x16 Lacc;
#pragma unroll
    for (int i = 0; i < 16; ++i) Lacc[i] = 0.f;
    const int qd = 32 * r + m;
    bf16x8 kf[8];
    load_K(kf, lds, koff);
    for (int t = 0; t < NT; ++t) {
        if (t + 3 < NT) ATT_DMA(t + 3);
        if (t < ntw) {
            load_K(kf, lds + (t & 3) * STG, koff);
            compute_S(SA0, SA1, kf, qf, 32 * r - 64 * t < 176, lut, qd - 64 * t, hi);
            softmax_pv(SA0, SA1, O, mrun, Lacc, t == 0, lds + (t & 3) * STG, voff, kf, lds + ((t + 1) & 3) * STG, koff, false);
        }
        if (t + 3 < NT) ATT_WAITBAR(4); else ATT_WAITBAR(0);
    }
#undef ATT_STEP
#undef ATT_DMA
#undef ATT_WAITBAR
    const float lrun = Lacc[0];
    const float sc = c ? lam / lrun : 1.0f / lrun;
    LAS f32x4* ex = (LAS f32x4*)(lds + slot * 16384 + lane * 64);
    if (c) {
#pragma unroll
        for (int d = 0; d < 4; ++d)
#pragma unroll
            for (int g = 0; g < 4; ++g) ex[d * 256 + g] = (f32x4){O[d][4 * g] * sc, O[d][4 * g + 1] * sc, O[d][4 * g + 2] * sc, O[d][4 * g + 3] * sc};
    }
    __syncthreads();
    if (!c) {
        float ss = 0.f;
#pragma unroll
        for (int d = 0; d < 4; ++d)
#pragma unroll
            for (int g = 0; g < 4; ++g) {
                const f32x4 o2 = ex[d * 256 + g];
#pragma unroll
                for (int e = 0; e < 4; ++e) { const float o = O[d][4 * g + e] * sc - o2[e]; O[d][4 * g + e] = o; ss += o * o; }
            }
        ss += __shfl_xor(ss, 32);
        const float rn = __builtin_amdgcn_rsqf(ss * (1.0f / 128.0f) + 1e-5f);
        bf16_t* orow = AA + (size_t)(b * SEQ + 32 * r + m) * 512 + h * 128 + 4 * hi;
#pragma unroll
        for (int d = 0; d < 4; ++d)
#pragma unroll
            for (int g = 0; g < 4; ++g) {
                u32x2 w; w.x = pk2bf(O[d][4 * g] * rn, O[d][4 * g + 1] * rn); w.y = pk2bf(O[d][4 * g + 2] * rn, O[d][4 * g + 3] * rn);
                *(u32x2*)(orow + 32 * d + 8 * g) = w;
            }
    }
    __syncthreads();
}
}

#define XB_TMO      128
#define XB_XCNT(j)  (256  + 64 * (j))
#define XB_XSUB(j)  (1280 + 64 * (j))
#define XB_XGEN(j)  (2304 + 64 * (j))
#define XB_TOP      3328
#define XB_TOPGEN   3392
#define XCD_BAR_WORDS 3456
#define XB_SPIN_CAP (1u << 18)

__device__ __forceinline__ unsigned xb_ld(unsigned* p)              { return __hip_atomic_load(p, __ATOMIC_RELAXED, __HIP_MEMORY_SCOPE_AGENT); }
__device__ __forceinline__ unsigned xb_add(unsigned* p, unsigned v) { return __hip_atomic_fetch_add(p, v, __ATOMIC_RELAXED, __HIP_MEMORY_SCOPE_AGENT); }
__device__ __forceinline__ unsigned xb_xcc_id() { return (unsigned)__builtin_amdgcn_s_getreg((3 << 11) | 20) & 0xFu; }
#define XB_SPIN(cond, bar) do { unsigned _sp = 0; while (cond) { __builtin_amdgcn_s_sleep(1); \
    if ((++_sp & 255u) == 0u) { if (xb_ld(&(bar)[XB_TMO])) break; if (_sp > XB_SPIN_CAP) { atomicAdd(&(bar)[XB_TMO], 1u); break; } } } } while (0)

struct XcdBarrier {
    unsigned* bar; unsigned x;
    volatile LAS unsigned* st;
};

__device__ __forceinline__ XcdBarrier xcd_barrier_post(unsigned* bar, volatile LAS unsigned* st) {
    XcdBarrier b; b.bar = bar; b.x = xb_xcc_id(); b.st = st;
    if (threadIdx.x == 0) (void)xb_add(&bar[XB_XCNT(b.x)], 1u);
    return b;
}
__device__ __forceinline__ void xcd_barrier_complete(unsigned* bar, unsigned x, unsigned& nloc, unsigned& nx) {
    const unsigned G = gridDim.x * gridDim.y * gridDim.z;
    unsigned sum, cnt, mine, sp = 0u;
    for (;;) {
        sum = 0u; cnt = 0u; mine = 0u;
#pragma unroll
        for (unsigned j = 0; j < 16; ++j) { const unsigned c = xb_ld(&bar[XB_XCNT(j)]); sum += c; cnt += (c > 0u) ? 1u : 0u; mine = (j == x) ? c : mine; }
        if (sum == G) break;
        __builtin_amdgcn_s_sleep(1);
        if ((++sp & 255u) == 0u) { if (xb_ld(&bar[XB_TMO])) break; if (sp > XB_SPIN_CAP) { atomicAdd(&bar[XB_TMO], 1u); break; } }
    }
    nloc = mine > 0u ? mine : 1u; nx = cnt > 0u ? cnt : 1u;
}

__device__ __forceinline__ void xcd_barrier(const XcdBarrier& b) {
    asm volatile("s_waitcnt vmcnt(0)" ::: "memory");
    __syncthreads();
    if (threadIdx.x == 0) {
        unsigned* bar = b.bar;
        __builtin_amdgcn_s_waitcnt(0);
        unsigned nloc = b.st[0], nx = b.st[1];
        if (nloc == 0u) { xcd_barrier_complete(bar, b.x, nloc, nx); b.st[0] = nloc; b.st[1] = nx; }
        const unsigned old = xb_add(&bar[XB_XSUB(b.x)], 1u);
        const unsigned gen = old / nloc;
        if (old + 1u == (gen + 1u) * nloc) {
            __builtin_amdgcn_fence(__ATOMIC_RELEASE, "agent");
            asm volatile("s_waitcnt vmcnt(0)" ::: "memory");
            const unsigned og = xb_add(&bar[XB_TOP], 1u);
            const unsigned tg = og / nx;
            if (og + 1u == (tg + 1u) * nx) xb_add(&bar[XB_TOPGEN], 1u);
            else XB_SPIN(xb_ld(&bar[XB_TOPGEN]) == tg, bar);
            __builtin_amdgcn_fence(__ATOMIC_ACQUIRE, "agent");
            xb_add(&bar[XB_XGEN(b.x)], 1u);
            asm volatile("s_waitcnt vmcnt(0)" ::: "memory");
        } else {
            XB_SPIN(xb_ld(&bar[XB_XGEN(b.x)]) == gen, bar);
            __builtin_amdgcn_fence(__ATOMIC_ACQUIRE, "agent");
            asm volatile("s_waitcnt vmcnt(0)" ::: "memory");
        }
    }
    __syncthreads();
}

__device__ __forceinline__ void tr_item(const float* W, int K, int N, bf16_t* WT, int drow0, int k0, int n0, const float* gk, int gmask, float gfac, LAS float* scr, int lane) {
    float wv[32], sv[32];
#pragma unroll
    for (int i = 0; i < 32; ++i) {
        const int kk = 2 * i + (lane >> 5);
        wv[i] = __builtin_nontemporal_load(W + (size_t)(k0 + kk) * N + n0 + (lane & 31));
        sv[i] = gk ? gk[(k0 + kk) & gmask] * gfac : 1.0f;
    }
#pragma unroll
    for (int i = 0; i < 32; ++i) scr[(2 * i + (lane >> 5)) * 33 + (lane & 31)] = wv[i] * sv[i];
    asm volatile("s_waitcnt lgkmcnt(0)" ::: "memory");
    const int c = lane & 7;
#pragma unroll
    for (int j = 0; j < 4; ++j) {
        const int n = (lane >> 3) + 8 * j; const LAS float* s = scr + (8 * c) * 33 + n;
        u32x4 o; o.x = pk2bf(s[0 * 33], s[1 * 33]); o.y = pk2bf(s[2 * 33], s[3 * 33]); o.z = pk2bf(s[4 * 33], s[5 * 33]); o.w = pk2bf(s[6 * 33], s[7 * 33]);
        *(u32x4*)(WT + (size_t)(drow0 + n) * K + k0 + 8 * c) = o;
    }
    asm volatile("s_waitcnt lgkmcnt(0)" ::: "memory");
}
__device__ __forceinline__ float lambda_init(int l) { return 0.8f - 0.6f * __expf(-0.3f * (float)l); }

__device__ __forceinline__ int first_pn(int N, int G, int bx) { pg8::StaticOrder S; S.init(MTOK, N, G, bx); pg8::Unit u; u.pm = 0; u.pn = 0; (void)S.next(0, u); return u.pn; }
struct Args { const float* in[22]; float* out; unsigned char* ws; int ph_lo, ph_hi; };
constexpr int ITEMS_PER_LAYER = 12032;
constexpr int LDS_DYN = 132 * 1024;

__global__ void __launch_bounds__(NTHR, 2) fwd_kernel(Args a) {
    extern __shared__ __attribute__((aligned(16))) unsigned char lds_raw[];
    LAS unsigned char* lds = (LAS unsigned char*)lds_raw;
    cg::grid_group grid = cg::this_grid();
    const int tid = threadIdx.x, lane = tid & 63, wid = __builtin_amdgcn_readfirstlane(tid >> 6);
    const int G = gridDim.x, bx = blockIdx.x;
    const int vcu = (G % 8 == 0) ? (bx % 8) * (G / 8) + bx / 8 : bx;
    unsigned char* ws = a.ws;
    const int lo = a.ph_lo, hi = a.ph_hi;
    int pc = 0;
    volatile LAS unsigned* MISC = (volatile LAS unsigned*)(lds + 131072 + 64);
    if (tid < 2) MISC[tid] = 0u;
    __syncthreads();
    XcdBarrier bar = xcd_barrier_post((unsigned*)(ws + 0), MISC);
#define PH_ON() (lo <= pc && pc < hi)
#define PH_END() do { if (lo <= pc && pc + 1 < hi) { if (lo > 1000000) grid.sync(); else xcd_barrier(bar); } ++pc; } while (0)

    if (PH_ON()) {
        LAS float* scr = (LAS float*)(lds + wid * 16384);
        const int gw = vcu * NWAVES + wid, NGW = G * NWAVES;
        for (int it = gw; it < DEPTH * ITEMS_PER_LAYER; it += NGW) {
            const int l = it / ITEMS_PER_LAYER; int r = it % ITEMS_PER_LAYER;
            unsigned char* wl = ws + WS_W + (size_t)l * LW_BYTES;
            if (r < 2816 || (r >= 7808 && r < 10624)) {
                const int second = r >= 7808; if (second) r -= 7808;
                const int up = r >= 1408; if (up) r -= 1408;
                const int kb = r / 88, nb = r % 88, n0 = 32 * nb, drow = (n0 >> 7) * 256 + up * 128 + (n0 & 127);
                const float* W = a.in[second ? (up ? 19 : 18) : (up ? 3 : 2)] + (size_t)l * DM * FF;
                tr_item(W, DM, FF, (bf16_t*)(wl + (second ? LW_GU2 : LW_GU1)), drow, 64 * kb, n0, a.in[second ? 17 : 1] + l * DM, 1023, 1.0f, scr, lane);
            } else if (r < 4224 || r >= 10624) {
                const int second = r >= 10624; r -= second ? 10624 : 2816;
                const int kb = r / 32, nb = r % 32;
                tr_item(a.in[second ? 20 : 4] + (size_t)l * FF * DM, FF, DM, (bf16_t*)(wl + (second ? LW_D2 : LW_D1)), 32 * nb, 64 * kb, 32 * nb, nullptr, 0, 1.0f, scr, lane);
            } else if (r < 6784) {
                r -= 4224; const int kb = r / 160, nb = r % 160, n0 = 32 * nb; int drow = n0;
                if (n0 >= 2048 && n0 < 2560) { const int j = n0 - 2048; drow = 2048 + (j >> 7) * 256 + (j & 127); }
                else if (n0 >= 2560 && n0 < 3072) { const int j = n0 - 2560; drow = 2048 + (j >> 7) * 256 + 128 + (j & 127); }
                tr_item(a.in[6] + (size_t)l * DM * NIN, DM, NIN, (bf16_t*)(wl + LW_IN), drow, 64 * kb, n0, a.in[5] + l * DM, 1023, 1.0f, scr, lane);
            } else if (r < 7040) {
                r -= 6784; const int kb = r / 32, nb = r % 32;
                tr_item(a.in[14] + (size_t)l * 512 * DM, 512, DM, (bf16_t*)(wl + LW_BR), 32 * nb, 64 * kb, 32 * nb, a.in[11] + l * 128, 127, 1.0f - lambda_init(l), scr, lane);
            } else if (r < 7296) {
                r -= 7040; const int kb = r / 32, nb = r % 32;
                tr_item(a.in[15] + (size_t)l * 512 * DM, 512, DM, (bf16_t*)(wl + LW_BR), 1024 + 32 * nb, 64 * kb, 32 * nb, nullptr, 0, 1.0f, scr, lane);
            } else {
                r -= 7296; const int kb = r / 32, nb = r % 32;
                tr_item(a.in[16] + (size_t)l * DM * DM, DM, DM, (bf16_t*)(wl + LW_OUT), 32 * nb, 64 * kb, 32 * nb, nullptr, 0, 1.0f, scr, lane);
            }
        }
        const float* x = a.in[0]; float* X = a.out; float* SSQ = (float*)(ws + WS_SSQ); bf16_t* XB = (bf16_t*)(ws + WS_XB);
        for (int mrow = gw; mrow < MTOK; mrow += NGW) {
            const f32x4* xr = (const f32x4*)(x + (size_t)mrow * DM) + lane;
            unsigned long long* xb8 = (unsigned long long*)(XB + (size_t)mrow * DM) + lane;
            float s = 0.f;
#pragma unroll
            for (int j = 0; j < 4; ++j) {
                const f32x4 v = xr[64 * j]; s += (v[0] * v[0] + v[1] * v[1]) + (v[2] * v[2] + v[3] * v[3]);
                xb8[64 * j] = (unsigned long long)pk2bf(v[0], v[1]) | ((unsigned long long)pk2bf(v[2], v[3]) << 32);
            }
            s = wave_sum(s);
            if (lane < 16) SSQ[(size_t)mrow * 16 + lane] = lane == 0 ? s : 0.f;
        }
    }
    PH_END();

#pragma unroll 1
    for (int f = 0; f < 2 * DEPTH; ++f) {
        const int l = f >> 1; const bool second = f & 1;
        unsigned char* wsl = a.ws; float* X = a.out; asm volatile("" : "+s"(wsl), "+s"(X));
        unsigned char* wl = wsl + WS_W + (size_t)l * LW_BYTES;
        float* SSQ = (float*)(wsl + WS_SSQ);
        bf16_t* XB = (bf16_t*)(wsl + WS_XB);
        bf16_t* ACT = (bf16_t*)(wsl + WS_ACT);
        bf16_t *Qb = (bf16_t*)(wsl + WS_Q), *Kb = (bf16_t*)(wsl + WS_K), *VTb = (bf16_t*)(wsl + WS_VT), *CBb = (bf16_t*)(wsl + WS_CB), *Pb = (bf16_t*)(wsl + WS_P),
               *GAb = (bf16_t*)(wsl + WS_GA), *GCb = (bf16_t*)(wsl + WS_GC), *AAb = (bf16_t*)(wsl + WS_AA), *MGb = (bf16_t*)(wsl + WS_MG);
        if (PH_ON()) {
            const int lane_l = fresh_lane(), tl = wid * 64 + lane_l;
            pg8::Gemm g{XB, (const bf16_t*)(wl + (second ? LW_GU2 : LW_GU1)), MTOK, NGU, DM}; pg8::StaticOrder S; S.init(MTOK, NGU, G, bx);
            pg8::EpiGU E{ACT, SSQ, (LAS float*)(lds + 132096)};
            const bf16_t* wd_ = (const bf16_t*)(wl + (second ? LW_D2 : LW_D1));
            pg8::gemm_phase<pg8::EpiGU, pg8::StaticOrder, true, true>(lds, g, S, E, tl, wd_ + (size_t)first_pn(DM, G, bx) * 256 * FF, FF, false, f > 0);
        }
        PH_END();
        if (PH_ON()) {
            const int lane_l = fresh_lane(), tl = wid * 64 + lane_l;
            pg8::Gemm g{ACT, (const bf16_t*)(wl + (second ? LW_D2 : LW_D1)), MTOK, DM, FF}; pg8::StaticOrder S; S.init(MTOK, DM, G, bx);
            pg8::EpiRes E{f == 0 ? a.in[0] : (const float*)X, X, XB, SSQ, 0.5f};
            const bf16_t* nb_ = !second ? (const bf16_t*)(wl + LW_IN) + (size_t)first_pn(NIN, G, bx) * 256 * DM
                              : (l + 1 < DEPTH ? (const bf16_t*)(wl + LW_BYTES + LW_GU1) + (size_t)first_pn(NGU, G, bx) * 256 * DM : (const bf16_t*)nullptr);
            pg8::gemm_phase<pg8::EpiRes, pg8::StaticOrder, true, true>(lds, g, S, E, tl, nb_, DM, true, true);
        }
        PH_END();
        if (second) continue;
        if (PH_ON()) {
            const int lane_l = fresh_lane(), tl = wid * 64 + lane_l;
            pg8::Gemm g{XB, (const bf16_t*)(wl + LW_IN), MTOK, NIN, DM}; pg8::StaticOrder S; S.init(MTOK, NIN, G, bx);
            pg8::EpiIn E{Qb, Kb, VTb, CBb, Pb, GAb, GCb, SSQ, (LAS float*)(lds + 132096)};
            pg8::gemm_phase<pg8::EpiIn, pg8::StaticOrder, true, true>(lds, g, S, E, tl, nullptr, 0, false, true);
        }
        PH_END();
        if (PH_ON()) {
            const int lane_l = fresh_lane(), tl = wid * 64 + lane_l;
            const float* cw = a.in[13] + (size_t)l * 3 * 512;
            bf16_t* AC = AAb + (size_t)MTOK * 512;
            for (int idx = bx * NTHR + tl; idx < MTOK * 64; idx += G * NTHR) {
                const int row = idx >> 6, c8 = (idx & 63) * 8, t = row & (SEQ - 1);
                const u32x4 z = {0u, 0u, 0u, 0u};
                const u32x4 p0 = *(const u32x4*)(Pb + (size_t)row * 512 + c8);
                const u32x4 p1 = t >= 1 ? *(const u32x4*)(Pb + (size_t)(row - 1) * 512 + c8) : z;
                const u32x4 p2 = t >= 2 ? *(const u32x4*)(Pb + (size_t)(row - 2) * 512 + c8) : z;
                const u32x4 cb = *(const u32x4*)(CBb + (size_t)row * 512 + c8);
                float o[8];
#pragma unroll
                for (int e = 0; e < 4; ++e) {
                    const float w0a = cw[c8 + 2 * e], w0b = cw[c8 + 2 * e + 1], w1a = cw[512 + c8 + 2 * e], w1b = cw[512 + c8 + 2 * e + 1], w2a = cw[1024 + c8 + 2 * e], w2b = cw[1024 + c8 + 2 * e + 1];
                    o[2 * e] = bflo(cb[e]) * (w0a * bflo(p2[e]) + w1a * bflo(p1[e]) + w2a * bflo(p0[e]));
                    o[2 * e + 1] = bfhi(cb[e]) * (w0b * bfhi(p2[e]) + w1b * bfhi(p1[e]) + w2b * bfhi(p0[e]));
                }
                u32x4 w; w.x = pk2bf(o[0], o[1]); w.y = pk2bf(o[2], o[3]); w.z = pk2bf(o[4], o[5]); w.w = pk2bf(o[6], o[7]);
                *(u32x4*)(AC + (size_t)row * 512 + c8) = w;
            }
            const float la = wave_sum(a.in[7][l * 64 + lane_l] * a.in[8][l * 64 + lane_l]), lb = wave_sum(a.in[9][l * 64 + lane_l] * a.in[10][l * 64 + lane_l]);
            const float lam = __builtin_bit_cast(float, __builtin_amdgcn_readfirstlane(__builtin_bit_cast(int, __expf(la) - __expf(lb) + lambda_init(l))));
#ifndef NO_ATT
            #pragma unroll 1
            for (int u2 = 0; u2 < 2; ++u2)
#pragma unroll 1
                for (int v = vcu; v < 256; v += G) att::attn_phase(lds, Qb, Kb, VTb, AAb, a.in[12], lam, (2 * (v >> 5) + u2) * 32 + (u2 ? 31 - (v & 31) : (v & 31)), tl, wid, lane_l);
#endif
        }
        PH_END();
        if (PH_ON()) {
            const int lane_l = fresh_lane(), tl = wid * 64 + lane_l;
#pragma unroll 1
            for (int gsel = 0; gsel < 2; ++gsel) {
                pg8::Gemm g{AAb + (size_t)gsel * MTOK * 512, (const bf16_t*)(wl + LW_BR) + (size_t)gsel * 1024 * 512, MTOK, DM, 512}; pg8::StaticOrder S; S.init(MTOK, DM, G, bx);
                pg8::EpiBr E{gsel ? GCb : GAb, MGb, gsel};
                const bf16_t* nb_ = gsel == 0 ? (const bf16_t*)(wl + LW_BR) + (size_t)1024 * 512 + (size_t)first_pn(DM, G, bx) * 256 * 512
                                              : (const bf16_t*)(wl + LW_OUT) + (size_t)first_pn(DM, G, bx) * 256 * DM;
                pg8::gemm_phase<pg8::EpiBr, pg8::StaticOrder, true, true>(lds, g, S, E, tl, nb_, gsel == 0 ? 512 : DM, gsel == 0, gsel == 1);
            }
        }
        PH_END();
        if (PH_ON()) {
            const int lane_l = fresh_lane(), tl = wid * 64 + lane_l;
            pg8::Gemm g{MGb, (const bf16_t*)(wl + LW_OUT), MTOK, DM, DM}; pg8::StaticOrder S; S.init(MTOK, DM, G, bx);
            pg8::EpiRes E{X, X, XB, SSQ, 1.0f};
            pg8::gemm_phase<pg8::EpiRes, pg8::StaticOrder, true, true>(lds, g, S, E, tl, (const bf16_t*)(wl + LW_GU2) + (size_t)first_pn(NGU, G, bx) * 256 * DM, DM, true, true);
        }
        PH_END();
    }
    if (PH_ON()) {
        const int gw = vcu * NWAVES + wid, NGW = G * NWAVES; const int lane = fresh_lane();
        const f32x4* gf = (const f32x4*)a.in[21] + lane; float* X = a.out;
        for (int mrow = gw; mrow < MTOK; mrow += NGW) {
            f32x4* xr = (f32x4*)(X + (size_t)mrow * DM) + lane;
            f32x4 v[4]; float s = 0.f;
#pragma unroll
            for (int j = 0; j < 4; ++j) { v[j] = xr[64 * j]; s += (v[j][0] * v[j][0] + v[j][1] * v[j][1]) + (v[j][2] * v[j][2] + v[j][3] * v[j][3]); }
            const float rstd = 1.0f / sqrtf(wave_sum(s) * (1.0f / DM) + 1e-6f);
#pragma unroll
            for (int j = 0; j < 4; ++j) xr[64 * j] = v[j] * rstd * gf[64 * j];
        }
    }
#undef PH_ON
#undef PH_END
}

constexpr int N_PHASES = 1 + DEPTH * 8 + 1;

extern "C" void kernel_launch(void* const* d_in, const int* in_sizes, int n_in, void* d_out, int out_size, void* d_ws, size_t ws_size, hipStream_t stream) {
    static int grid = 0;
    if (grid == 0) {
        if (n_in != 22 || in_sizes[0] != MTOK * DM || out_size != MTOK * DM || ws_size < WS_END) {
            fprintf(stderr, "kernel_launch: unexpected shapes (n_in %d, in0 %d, out %d, ws %zu < %zu)\n", n_in, n_in > 0 ? in_sizes[0] : -1, out_size, ws_size, (size_t)WS_END);
            grid = -1; return;
        }
        int dev = 0, cus = 0, per_cu = 0;
        (void)hipGetDevice(&dev);
        (void)hipDeviceGetAttribute(&cus, hipDeviceAttributeMultiprocessorCount, dev);
        (void)hipFuncSetAttribute((const void*)fwd_kernel, hipFuncAttributeMaxDynamicSharedMemorySize, LDS_DYN);
        (void)hipOccupancyMaxActiveBlocksPerMultiprocessor(&per_cu, (const void*)fwd_kernel, NTHR, LDS_DYN);
        (void)hipGetLastError();
        if (cus <= 0) cus = 256;
        grid = cus;
        if (per_cu < 1) fprintf(stderr, "kernel_launch: occupancy query says %d blocks per CU\n", per_cu);
    }
    if (grid < 0) return;
    (void)hipMemsetAsync(d_ws, 0, 16384, stream);
    Args a{};
    for (int i = 0; i < 22; ++i) a.in[i] = (const float*)d_in[i];
    a.out = (float*)d_out; a.ws = (unsigned char*)d_ws; a.ph_lo = 0; a.ph_hi = N_PHASES;
    void* args[] = {&a};
    hipError_t e = hipLaunchCooperativeKernel((const void*)fwd_kernel, dim3(grid), dim3(NTHR), args, LDS_DYN, stream);
    if (e != hipSuccess) fprintf(stderr, "kernel_launch: cooperative launch failed: %s (grid %d)\n", hipGetErrorString(e), grid);
}
```
